# Optimizing an MI355X kernel written in HIP

```python
import math
import jax, jax.numpy as jnp
from jax import lax
import numpy as np

D_MODEL = 2048
BATCH = 8
SEQ = 4096
DEPTH = 1

CHUNK = 64
D_MIX = D_MODEL
D_LRU = D_MIX // 2
N_LRU_HEADS = 8
LRU_HEAD_DIM = D_LRU // N_LRU_HEADS
D_SC = D_MIX - D_LRU
N_SC_GROUPS = 16
SC_GROUP_DIM = D_SC // N_SC_GROUPS
LRU_CONV_W = 4
SC_CONV_W = 3
RG_C = 8.0
D_FF = 5632
EPS = 1e-6
D_IN = 2 * D_LRU + 3 * D_SC

kernel_name = "hybrid_rglru_shortconv_macaron_block"


def rmsnorm(x, g):
    xf = x.astype(jnp.float32)
    y = xf * lax.rsqrt(jnp.mean(xf * xf, axis=-1, keepdims=True) + EPS)
    return (y * g.astype(jnp.float32)).astype(x.dtype)


def swiglu(x, w_gate, w_up, w_down):
    return (jax.nn.silu(x @ w_gate) * (x @ w_up)) @ w_down


def causal_dwconv(x, w, b=None):
    k_w = w.shape[0]
    s = x.shape[1]
    xp = jnp.pad(x, ((0, 0), (k_w - 1, 0), (0, 0)))
    y = xp[:, 0:s] * w[0]
    for k in range(1, k_w):
        y = y + xp[:, k:k + s] * w[k]
    if b is not None:
        y = y + b
    return y


def rg_lru(x, w_r, b_r, w_i, b_i, lam):
    bsz, s, _ = x.shape
    xh = x.reshape(bsz, s, N_LRU_HEADS, LRU_HEAD_DIM)
    r = jax.nn.sigmoid(jnp.einsum('bshd,hde->bshe', xh, w_r) + b_r).reshape(bsz, s, D_LRU)
    i = jax.nn.sigmoid(jnp.einsum('bshd,hde->bshe', xh, w_i) + b_i).reshape(bsz, s, D_LRU)
    log_a = -RG_C * r.astype(jnp.float32) * jax.nn.softplus(-lam.astype(jnp.float32))
    a = jnp.exp(log_a)
    mult = jnp.sqrt(-jnp.expm1(2.0 * log_a))
    b = mult * (i.astype(jnp.float32) * x.astype(jnp.float32))

    def combine(left, right):
        a_l, b_l = left
        a_r, b_r_ = right
        return a_l * a_r, a_r * b_l + b_r_

    _, h = lax.associative_scan(combine, (a, b), axis=1)
    return h.astype(x.dtype)


def setup_inputs(seed: int = 0) -> dict:
    key = jax.random.key(seed)
    ks = jax.random.split(key, 32)
    f32 = jnp.float32

    def nrm(k, shape, fan_in):
        return jax.random.normal(k, shape, f32) * (fan_in ** -0.5)

    def gain(k, shape):
        return 1.0 + 0.05 * jax.random.normal(k, shape, f32)

    L = DEPTH
    u = jax.random.uniform(ks[20], (L, D_LRU), f32, 0.9, 0.999)
    a0 = u ** (1.0 / RG_C)
    lam = jnp.log(a0) - jnp.log1p(-a0)
    return {
        "x": jax.random.normal(ks[0], (BATCH, SEQ, D_MODEL), f32),
        "ffn1_pre_g": gain(ks[1], (L, D_MODEL)),
        "ffn1_w_gate": nrm(ks[2], (L, D_MODEL, D_FF), D_MODEL),
        "ffn1_w_up": nrm(ks[3], (L, D_MODEL, D_FF), D_MODEL),
        "ffn1_w_down": nrm(ks[4], (L, D_FF, D_MODEL), D_FF),
        "ffn1_post_g": gain(ks[5], (L, D_MODEL)),
        "mix_pre_g": gain(ks[6], (L, D_MODEL)),
        "w_in": nrm(ks[7], (L, D_MODEL, D_IN), D_MODEL),
        "lru_conv_w": nrm(ks[8], (L, LRU_CONV_W, D_LRU), LRU_CONV_W),
        "lru_conv_b": 0.01 * jax.random.normal(ks[9], (L, D_LRU), f32),
        "lru_w_r": nrm(ks[10], (L, N_LRU_HEADS, LRU_HEAD_DIM, LRU_HEAD_DIM), LRU_HEAD_DIM),
        "lru_b_r": 0.01 * jax.random.normal(ks[11], (L, N_LRU_HEADS, LRU_HEAD_DIM), f32),
        "lru_w_i": nrm(ks[12], (L, N_LRU_HEADS, LRU_HEAD_DIM, LRU_HEAD_DIM), LRU_HEAD_DIM),
        "lru_b_i": 0.01 * jax.random.normal(ks[13], (L, N_LRU_HEADS, LRU_HEAD_DIM), f32),
        "lru_lambda": lam,
        "sc_conv_w": nrm(ks[14], (L, SC_CONV_W, D_SC), SC_CONV_W),
        "w_out": nrm(ks[15], (L, D_MIX, D_MODEL), D_MIX),
        "mix_post_g": gain(ks[16], (L, D_MODEL)),
        "ffn2_pre_g": gain(ks[17], (L, D_MODEL)),
        "ffn2_w_gate": nrm(ks[18], (L, D_MODEL, D_FF), D_MODEL),
        "ffn2_w_up": nrm(ks[19], (L, D_MODEL, D_FF), D_MODEL),
        "ffn2_w_down": nrm(ks[21], (L, D_FF, D_MODEL), D_FF),
        "ffn2_post_g": gain(ks[22], (L, D_MODEL)),
    }


def reference(x, ffn1_pre_g, ffn1_w_gate, ffn1_w_up, ffn1_w_down, ffn1_post_g,
              mix_pre_g, w_in, lru_conv_w, lru_conv_b, lru_w_r, lru_b_r, lru_w_i, lru_b_i,
              lru_lambda, sc_conv_w, w_out, mix_post_g,
              ffn2_pre_g, ffn2_w_gate, ffn2_w_up, ffn2_w_down, ffn2_post_g):
    h = x
    for l in range(DEPTH):
        f = swiglu(rmsnorm(h, ffn1_pre_g[l]), ffn1_w_gate[l], ffn1_w_up[l], ffn1_w_down[l])
        h = h + 0.5 * rmsnorm(f, ffn1_post_g[l])

        u = rmsnorm(h, mix_pre_g[l])
        z = u @ w_in[l]
        o = np.cumsum([0, D_LRU, D_LRU, D_SC, D_SC, D_SC]).tolist()
        lru_x = z[..., o[0]:o[1]]
        lru_gate = z[..., o[1]:o[2]]
        sc_b = z[..., o[2]:o[3]]
        sc_c = z[..., o[3]:o[4]]
        sc_x = z[..., o[4]:o[5]]

        xc = causal_dwconv(lru_x, lru_conv_w[l], lru_conv_b[l])
        y_lru = rg_lru(xc, lru_w_r[l], lru_b_r[l], lru_w_i[l], lru_b_i[l], lru_lambda[l])
        y_lru = y_lru * jax.nn.gelu(lru_gate)

        y_sc = sc_b * causal_dwconv(sc_c * sc_x, sc_conv_w[l])

        y = jnp.concatenate([y_lru, y_sc], axis=-1) @ w_out[l]
        h = h + rmsnorm(y, mix_post_g[l])

        f = swiglu(rmsnorm(h, ffn2_pre_g[l]), ffn2_w_gate[l], ffn2_w_up[l], ffn2_w_down[l])
        h = h + 0.5 * rmsnorm(f, ffn2_post_g[l])
    return h
```

```cpp
#include <hip/hip_runtime.h>
#include <hip/hip_cooperative_groups.h>
#include <cstdio>
namespace cg = cooperative_groups;

#define LAS __attribute__((address_space(3)))
typedef unsigned short bf16_t;
typedef short bf16x8 __attribute__((ext_vector_type(8)));
typedef float f32x4 __attribute__((ext_vector_type(4)));
typedef unsigned u32x4 __attribute__((ext_vector_type(4)));
typedef unsigned u32x2 __attribute__((ext_vector_type(2)));
typedef float f32x2 __attribute__((ext_vector_type(2)));

constexpr int M_TOK = 32768, DM = 2048, DFF = 5632, DIN = 5120, SEQ = 4096;
constexpr float EPS = 1e-6f;
constexpr int LDS_BYTES = 131072 + 16;

constexpr size_t SZ_WGU = (size_t)2 * DFF * DM * 2, SZ_WD = (size_t)DM * DFF * 2, SZ_WIN = (size_t)DIN * DM * 2, SZ_WOUT = (size_t)DM * DM * 2;
constexpr size_t WS_WGU1 = 0, WS_WD1 = WS_WGU1 + SZ_WGU, WS_WIN = WS_WD1 + SZ_WD, WS_WOUT = WS_WIN + SZ_WIN, WS_WGU2 = WS_WOUT + SZ_WOUT, WS_WD2 = WS_WGU2 + SZ_WGU;
constexpr size_t WS_WR = WS_WD2 + SZ_WD, WS_WI = WS_WR + 262144, WS_AGG = WS_WI + 262144, WS_BAR = WS_AGG + 524288;
constexpr size_t WS_RS = WS_AGG + 786432;
constexpr size_t WS_A1 = WS_AGG + 1048576, WS_HB = WS_A1 + (size_t)M_TOK * DM * 2, WS_F = WS_HB + (size_t)M_TOK * DFF * 2, WS_Y = WS_F + (size_t)M_TOK * DM * 2, WS_END = WS_Y + (size_t)M_TOK * DM * 2;

struct Params { const float* in[23]; float* out; unsigned char* ws; };

__device__ __forceinline__ unsigned pk_bf16(float lo, float hi) { unsigned r; asm("v_cvt_pk_bf16_f32 %0, %1, %2" : "=v"(r) : "v"(lo), "v"(hi)); return r; }
__device__ __forceinline__ float bf_lo(unsigned w) { return __uint_as_float(w << 16); }
__device__ __forceinline__ float bf_hi(unsigned w) { return __uint_as_float(w & 0xffff0000u); }
__device__ __forceinline__ float bf2f(bf16_t h) { return __uint_as_float(((unsigned)h) << 16); }
__device__ __forceinline__ float wave_sum(float v) {
#pragma unroll
    for (int o = 32; o >= 1; o >>= 1) v += __shfl_xor(v, o);
    return v;
}
__device__ __forceinline__ size_t blk_off(int row, int col, int nrows) { return ((size_t)(col >> 6) * nrows + row) * 64 + (col & 63); }
__device__ __forceinline__ float sigmoidf_fast(float v) { return __builtin_amdgcn_rcpf(1.0f + __expf(-v)); }

namespace pg8 {
constexpr int BM = 256, BK = 64, HALF = 128, HTB = HALF * BK * 2, STAGE_BYTES = 8 * HTB, NXCD = 8, WGM = 8;
__device__ __forceinline__ int lds_byte(int r, int c) { const int st = (r >> 4) * 2 + (c >> 5), rr = r & 15, cc = c & 31, ob = rr * 64 + cc * 2; return st * 1024 + (ob ^ (((ob >> 9) & 1) << 5)); }
__device__ __forceinline__ void stage_rc(int b, int& R, int& C) { const int st = b / 1024, sb = b % 1024, swz = sb ^ (((sb >> 9) & 1) << 5); R = (st >> 1) * 16 + swz / 64; C = (st & 1) * 32 + (swz % 64) / 2; }
__device__ __forceinline__ int perm32(int rho) { const int n = rho >> 4, i = rho & 15; return 8 * (i >> 2) + 4 * n + (i & 3); }

struct Unit { int pm, pn; };
struct Gemm { const bf16_t* A; const bf16_t* Bt; int M, N, K; };

struct StaticOrder {
    int nM, nN, nwg, G, c, wgm;
    __device__ void init(int M, int N, int G_, int c_, int wgm_ = WGM) { nM = M / BM; nN = N / BM; nwg = nM * nN; G = G_; c = c_; wgm = wgm_; }
    __device__ bool next(int i, Unit& u) const {
        const long L = (long)i * G + c; if (L >= nwg) return false;
        int wgid = (int)L; { const int q = nwg / NXCD, r = nwg % NXCD, xcd = wgid % NXCD, off = wgid / NXCD; wgid = (xcd < r ? xcd * (q + 1) : r * (q + 1) + (xcd - r) * q) + off; }
        const int nig = wgm * nN, gid = wgid / nig, fm = gid * wgm, gsz = (nM - fm) < wgm ? (nM - fm) : wgm;
        u.pm = fm + ((wgid % nig) % gsz); u.pn = (wgid % nig) / gsz; return true;
    }
};

struct EpiBf16 {
    static constexpr bool PERM = true;
    bf16_t* O; int ldc;
    __device__ __forceinline__ void operator()(const f32x4 (&acc)[2][2][4][2], const Unit& u, int wr, int wc, int fr, int fq) const {
        const int row0 = u.pm * BM + wr * 64 + fr; const int col0 = u.pn * BM + wc * 32 + 8 * fq;
#pragma unroll
        for (int ai = 0; ai < 2; ++ai)
#pragma unroll
            for (int m = 0; m < 4; ++m) { bf16_t* rowp = O + (size_t)(row0 + ai * HALF + m * 16) * ldc + col0;
#pragma unroll
                for (int bj = 0; bj < 2; ++bj) { const f32x4 v0 = acc[ai][bj][m][0], v1 = acc[ai][bj][m][1];
                    u32x4 w; w.x = pk_bf16(v0[0], v0[1]); w.y = pk_bf16(v0[2], v0[3]); w.z = pk_bf16(v1[0], v1[1]); w.w = pk_bf16(v1[2], v1[3]);
                    *(u32x4*)(rowp + bj * HALF) = w; } }
    }
};
struct EpiSwiGLU {
    static constexpr bool PERM = false;
    bf16_t* O; int nrows;
    __device__ __forceinline__ void operator()(const f32x4 (&acc)[2][2][4][2], const Unit& u, int wr, int wc, int fr, int fq) const {
        const int row0 = u.pm * BM + wr * 64 + fr; const int col0 = u.pn * HALF + wc * 32 + 8 * fq;
#pragma unroll
        for (int ai = 0; ai < 2; ++ai)
#pragma unroll
            for (int m = 0; m < 4; ++m) { bf16_t* rowp = O + blk_off(row0 + ai * HALF + m * 16, col0, nrows);
                float v[8];
#pragma unroll
                for (int bj = 0; bj < 2; ++bj)
#pragma unroll
                    for (int j = 0; j < 4; ++j) { const float g = acc[ai][bj][m][0][j], up = acc[ai][bj][m][1][j]; v[bj * 4 + j] = g * sigmoidf_fast(g) * up; }
                u32x4 w; w.x = pk_bf16(v[0], v[1]); w.y = pk_bf16(v[2], v[3]); w.z = pk_bf16(v[4], v[5]); w.w = pk_bf16(v[6], v[7]);
                *(u32x4*)rowp = w; }
    }
};

template <class Epi>
__device__ __forceinline__ void gemm_phase(LAS unsigned char* lds, const Gemm g, const StaticOrder& S, const Epi& E) {
    int tid = threadIdx.x; asm volatile("" : "+v"(tid));
    const int wid = __builtin_amdgcn_readfirstlane(tid >> 6), lane = tid & 63, wr = wid >> 2, wc = wid & 3, fr = lane & 15, fq = lane >> 4;
    const int K = g.K, nt = K / BK;
    unsigned voffA[2], voffB[2];
#pragma unroll
    for (int i = 0; i < 2; ++i) { int R, C; stage_rc(tid * 16 + i * 8192, R, C); const int Rb = Epi::PERM ? ((R & ~31) + perm32(R & 31)) : R;
        voffA[i] = (unsigned)(R * BK + C) * 2u; voffB[i] = (unsigned)(Rb * BK + C) * 2u; }
    const size_t kstepA = (size_t)g.M * BK * 2, kstepB = (size_t)g.N * BK * 2;
    const size_t hstep = (size_t)HALF * BK * 2;
    const size_t tstep = 2 * hstep;
    const unsigned ldsw = (unsigned)wid * 1024u;
    const int aoff = lds_byte(wr * 64 + fr, fq * 8), boff = lds_byte(wc * 32 + fr, fq * 8);
#define PG8_SA(b, h) (((b) * 2 + (h)) * HTB)
#define PG8_SB(b, h) ((4 + (b) * 2 + (h)) * HTB)
#define PG8_STAGE(bufoff, gbase, voff) do { _Pragma("unroll") for (int _i = 0; _i < 2; ++_i) \
        __builtin_amdgcn_global_load_lds((const unsigned*)((const char*)(gbase) + (voff)[_i]), (LAS unsigned*)(lds + (bufoff) + ldsw + _i * 8192), 16, 0, 0); } while (0)
#define PG8_LDA(dst, b, h) do { _Pragma("unroll") for (int m = 0; m < 4; ++m) _Pragma("unroll") for (int k = 0; k < 2; ++k) dst[m][k] = *(const LAS bf16x8*)(lds + PG8_SA(b, h) + aoff + m * 2048 + k * 1024); } while (0)
#define PG8_LDB(dst, b, h) do { _Pragma("unroll") for (int n = 0; n < 2; ++n) _Pragma("unroll") for (int k = 0; k < 2; ++k) dst[n][k] = *(const LAS bf16x8*)(lds + PG8_SB(b, h) + boff + n * 2048 + k * 1024); } while (0)
#define PG8_MMA(ai, bj, At, Bt) do { __builtin_amdgcn_s_setprio(1); _Pragma("unroll") for (int m = 0; m < 4; ++m) _Pragma("unroll") for (int n = 0; n < 2; ++n) _Pragma("unroll") for (int k = 0; k < 2; ++k) \
        acc[ai][bj][m][n] = __builtin_amdgcn_mfma_f32_16x16x32_bf16(Bt[n][k], At[m][k], acc[ai][bj][m][n], 0, 0, 0); __builtin_amdgcn_s_setprio(0); } while (0)
#define PG8_WAIT_V(n) asm volatile("s_waitcnt vmcnt(" #n ")" ::: "memory")
#define PG8_WAIT_L(n) asm volatile("s_waitcnt lgkmcnt(" #n ")" ::: "memory")
#define PG8_BAR __builtin_amdgcn_s_barrier()
#define PG8_SCHED __builtin_amdgcn_sched_barrier(0)
    Unit cur, nxt; int ui = 0;
    if (!S.next(0, cur)) return;
    f32x4 acc[2][2][4][2];
#pragma unroll
    for (int a = 0; a < 2; ++a)
#pragma unroll
        for (int b = 0; b < 2; ++b)
#pragma unroll
            for (int m = 0; m < 4; ++m)
#pragma unroll
                for (int n = 0; n < 2; ++n) acc[a][b][m][n] = (f32x4){0.f, 0.f, 0.f, 0.f};
    bf16x8 At[4][2], B0[2][2], B1[2][2];
    const char* cA = (const char*)g.A + (size_t)cur.pm * tstep; const char* cB = (const char*)g.Bt + (size_t)cur.pn * tstep;
    PG8_STAGE(PG8_SB(0, 0), cB, voffB); PG8_STAGE(PG8_SA(0, 0), cA, voffA); PG8_STAGE(PG8_SB(0, 1), cB + hstep, voffB); PG8_STAGE(PG8_SA(0, 1), cA + hstep, voffA);
    if (wr == 1) PG8_BAR;
    PG8_WAIT_V(4); PG8_BAR;
    PG8_STAGE(PG8_SB(1, 0), cB + kstepB, voffB); PG8_STAGE(PG8_SA(1, 0), cA + kstepA, voffA); PG8_STAGE(PG8_SB(1, 1), cB + hstep + kstepB, voffB);
    PG8_WAIT_V(6); PG8_BAR;
    for (;;) {
        const bool has_next = S.next(ui + 1, nxt);
        const char* nA = has_next ? (const char*)g.A + (size_t)nxt.pm * tstep : cA; const char* nB = has_next ? (const char*)g.Bt + (size_t)nxt.pn * tstep : cB;
        for (int t = 0; t < nt; t += 2) {
            const bool last = (t == nt - 2);
            const char* a1 = cA + (size_t)(t + 1) * kstepA;
            const char* a2 = last ? nA : cA + (size_t)(t + 2) * kstepA; const char* b2 = last ? nB : cB + (size_t)(t + 2) * kstepB;
            const char* a3 = a2 + kstepA; const char* b3 = b2 + kstepB;
            PG8_LDB(B0, 0, 0); PG8_SCHED; PG8_LDA(At, 0, 0); PG8_STAGE(PG8_SA(1, 1), a1 + hstep, voffA);
            PG8_WAIT_L(8); PG8_BAR; PG8_WAIT_L(0); PG8_MMA(0, 0, At, B0); PG8_BAR; PG8_SCHED;
            PG8_LDB(B1, 0, 1); PG8_STAGE(PG8_SB(0, 0), b2, voffB);
            PG8_BAR; PG8_WAIT_L(0); PG8_MMA(0, 1, At, B1); PG8_BAR;
            PG8_LDA(At, 0, 1); PG8_STAGE(PG8_SA(0, 0), a2, voffA);
            PG8_BAR; PG8_WAIT_L(0); PG8_MMA(1, 0, At, B0); PG8_BAR; PG8_SCHED;
            PG8_STAGE(PG8_SB(0, 1), b2 + hstep, voffB);
            PG8_WAIT_V(6); PG8_BAR; PG8_MMA(1, 1, At, B1); PG8_BAR;
            PG8_LDB(B0, 1, 0); PG8_SCHED; PG8_LDA(At, 1, 0); PG8_STAGE(PG8_SA(0, 1), a2 + hstep, voffA);
            PG8_WAIT_L(8); PG8_BAR; PG8_WAIT_L(0); PG8_MMA(0, 0, At, B0); PG8_BAR; PG8_SCHED;
            PG8_LDB(B1, 1, 1); PG8_STAGE(PG8_SB(1, 0), b3, voffB);
            PG8_BAR; PG8_WAIT_L(0); PG8_MMA(0, 1, At, B1); PG8_BAR;
            PG8_LDA(At, 1, 1); PG8_STAGE(PG8_SA(1, 0), a3, voffA);
            PG8_BAR; PG8_WAIT_L(0); PG8_MMA(1, 0, At, B0); PG8_BAR; PG8_SCHED;
            PG8_STAGE(PG8_SB(1, 1), b3 + hstep, voffB);
            PG8_WAIT_V(6); PG8_BAR; PG8_MMA(1, 1, At, B1); PG8_BAR;
        }
        E(acc, cur, wr, wc, fr, fq);
        if (!has_next) break;
#pragma unroll
        for (int a = 0; a < 2; ++a)
#pragma unroll
            for (int b = 0; b < 2; ++b)
#pragma unroll
                for (int m = 0; m < 4; ++m)
#pragma unroll
                    for (int n = 0; n < 2; ++n) acc[a][b][m][n] = (f32x4){0.f, 0.f, 0.f, 0.f};
        cur = nxt; cA = nA; cB = nB; ++ui;
    }
    PG8_WAIT_V(0);
    if (wr == 0) PG8_BAR;
    PG8_BAR;
#undef PG8_SA
#undef PG8_SB
#undef PG8_STAGE
#undef PG8_LDA
#undef PG8_LDB
#undef PG8_MMA
#undef PG8_WAIT_V
#undef PG8_WAIT_L
#undef PG8_BAR
#undef PG8_SCHED
}
}

constexpr int CV_PITCH = 260;
struct CvTile { const float* s0; const float* gk; bf16_t* dst; long d1; int K, Nsrc, mode, lt; };
__device__ __forceinline__ void cv_desc(const Params& p, int gt, CvTile& t) {
    const float* s0; const float* s1 = nullptr; const float* gk = nullptr; size_t doff; int K, Nsrc, mode = 0, lt;
    if (gt < 1408)      { s0 = p.in[2]; s1 = p.in[3]; gk = p.in[1]; doff = WS_WGU1; K = DM; Nsrc = DFF; mode = 1; lt = gt; }
    else if (gt < 2112) { s0 = p.in[4]; doff = WS_WD1; K = DFF; Nsrc = DM; lt = gt - 1408; }
    else if (gt < 2752) { s0 = p.in[7]; gk = p.in[6]; doff = WS_WIN; K = DM; Nsrc = DIN; lt = gt - 2112; }
    else if (gt < 3008) { s0 = p.in[16]; doff = WS_WOUT; K = DM; Nsrc = DM; lt = gt - 2752; }
    else if (gt < 4416) { s0 = p.in[19]; s1 = p.in[20]; gk = p.in[18]; doff = WS_WGU2; K = DM; Nsrc = DFF; mode = 1; lt = gt - 3008; }
    else                { s0 = p.in[21]; doff = WS_WD2; K = DFF; Nsrc = DM; lt = gt - 4416; }
    t.s0 = s0; t.gk = gk; t.dst = (bf16_t*)(p.ws + doff); t.d1 = mode ? (long)(s1 - s0) : 0; t.K = K; t.Nsrc = Nsrc; t.mode = mode; t.lt = lt;
}
__device__ __forceinline__ void cv_load(const CvTile& t, f32x4 (&v)[8], float (&gs)[8]) {
    const int tid = threadIdx.x, nkt = t.K / 64, pn = t.lt / nkt, kt = t.lt % nkt;
#pragma unroll
    for (int i = 0; i < 8; ++i) {
        const int idx = tid + 512 * i, k = idx >> 6, c = (idx & 63) * 4;
        long off;
        if (t.mode) off = (long)(kt * 64 + k) * t.Nsrc + pn * 128 + (c & 127) + ((c & 128) ? t.d1 : 0);
        else off = (long)(kt * 64 + k) * t.Nsrc + pn * 256 + c;
        v[i] = *(const f32x4*)(t.s0 + off);
        gs[i] = t.gk ? t.gk[kt * 64 + k] : 1.0f;
    }
}
template <bool LRU_W>
__device__ __forceinline__ void phase_convert(const Params& p, unsigned char* ldsg, const int lo, const int hi) {
    bf16_t* T = (bf16_t*)ldsg;
    const int tid = threadIdx.x;
    int gt = lo + blockIdx.x;
    f32x4 v[8]; float gs[8];
    CvTile t; cv_desc(p, gt < hi ? gt : lo, t);
    if (gt < hi) cv_load(t, v, gs);
    for (; gt < hi; gt += gridDim.x) {
#pragma unroll
        for (int i = 0; i < 8; ++i) { const int idx = tid + 512 * i, k = idx >> 6, c = (idx & 63) * 4; const f32x4 x = v[i] * gs[i];
            u32x2 w; w.x = pk_bf16(x[0], x[1]); w.y = pk_bf16(x[2], x[3]); *(u32x2*)(T + k * CV_PITCH + c) = w; }
        __syncthreads();
        const CvTile cur = t;
        const int gn = gt + gridDim.x;
        if (gn < hi) { cv_desc(p, gn, t); cv_load(t, v, gs); }
        const int nkt = cur.K / 64, pn = cur.lt / nkt, kt = cur.lt % nkt, ndst = cur.mode ? 2 * cur.Nsrc : cur.Nsrc;
#pragma unroll
        for (int q = tid; q < 2048; q += 512) {
            const int r = q >> 3, kc = q & 7;
            int c = r;
            if (cur.mode) { const int bj = r >> 7, wc = (r >> 5) & 3, sgu = (r >> 4) & 1, fq = (r >> 2) & 3, e = r & 3; c = sgu * 128 + wc * 32 + fq * 8 + bj * 4 + e; }
            unsigned short x[8];
#pragma unroll
            for (int j = 0; j < 8; ++j) x[j] = T[(kc * 8 + j) * CV_PITCH + c];
            u32x4 o; o.x = x[0] | ((unsigned)x[1] << 16); o.y = x[2] | ((unsigned)x[3] << 16); o.z = x[4] | ((unsigned)x[5] << 16); o.w = x[6] | ((unsigned)x[7] << 16);
            *(u32x4*)(cur.dst + ((size_t)kt * ndst + (pn * 256 + r)) * 64 + kc * 8) = o;
        }
        __syncthreads();
    }
    bf16_t* WrT = (bf16_t*)(p.ws + WS_WR); bf16_t* WiT = (bf16_t*)(p.ws + WS_WI);
    if (LRU_W) for (int idx = blockIdx.x * 512 + threadIdx.x; idx < 131072; idx += gridDim.x * 512) {
        const int h = idx >> 14, e = (idx >> 7) & 127, d = idx & 127;
        WrT[idx] = (bf16_t)(pk_bf16(p.in[10][h * 16384 + d * 128 + e], 0.f) & 0xffffu);
        WiT[idx] = (bf16_t)(pk_bf16(p.in[12][h * 16384 + d * 128 + e], 0.f) & 0xffffu);
    }
}

__device__ void phase_prenorm(const float* __restrict__ x, bf16_t* __restrict__ xb, float* __restrict__ rs) {
    const int lane = threadIdx.x & 63, wid = threadIdx.x >> 6;
    const int nw = gridDim.x * 8;
    if ((M_TOK % (2 * nw)) != 0) return;
    for (int row = blockIdx.x * 8 + wid; row < M_TOK; row += 2 * nw) {
        f32x4 v[2][4][2]; float ss[2];
#pragma unroll
        for (int rr = 0; rr < 2; ++rr) { const float* xr = x + (size_t)(row + rr * nw) * DM + 8 * lane;
#pragma unroll
            for (int i = 0; i < 4; ++i) { v[rr][i][0] = *(const f32x4*)(xr + 512 * i); v[rr][i][1] = *(const f32x4*)(xr + 512 * i + 4); } }
#pragma unroll
        for (int rr = 0; rr < 2; ++rr) { float a = 0.f;
#pragma unroll
            for (int i = 0; i < 4; ++i)
#pragma unroll
                for (int j = 0; j < 4; ++j) a += v[rr][i][0][j] * v[rr][i][0][j] + v[rr][i][1][j] * v[rr][i][1][j];
            ss[rr] = wave_sum(a); }
#pragma unroll
        for (int rr = 0; rr < 2; ++rr) { bf16_t* ar = xb + blk_off(row + rr * nw, 8 * lane, M_TOK);
            const float ms = ss[rr] * (1.0f / DM) + EPS, rstd = rsqrtf(ms);
            if (lane == 0) rs[row + rr * nw] = sqrtf(ms);
#pragma unroll
            for (int i = 0; i < 4; ++i) { const f32x4 o0 = v[rr][i][0] * rstd, o1 = v[rr][i][1] * rstd;
                u32x4 w; w.x = pk_bf16(o0[0], o0[1]); w.y = pk_bf16(o0[2], o0[3]); w.z = pk_bf16(o1[0], o1[1]); w.w = pk_bf16(o1[2], o1[3]);
                *(u32x4*)(ar + (size_t)i * 8 * M_TOK * 64) = w; } }
    }
}

template <bool RESF32, bool OUTF32>
__device__ __forceinline__ void phase_norm(const bf16_t* __restrict__ F, const float* __restrict__ resf, bf16_t* hb, float* __restrict__ outf, float* __restrict__ rs, const float* __restrict__ gpost, float coef) {
    const int lane = threadIdx.x & 63, wid = threadIdx.x >> 6;
    const int nw = gridDim.x * 8;
    for (int row = blockIdx.x * 8 + wid; row < M_TOK; row += 2 * nw) {
        u32x4 fraw[2][4]; f32x4 h[2][4][2];
#pragma unroll
        for (int rr = 0; rr < 2; ++rr) { const size_t ro = (size_t)(row + rr * nw) * DM + 8 * lane;
#pragma unroll
            for (int i = 0; i < 4; ++i) { fraw[rr][i] = *(const u32x4*)(F + ro + 512 * i);
                if (RESF32) { h[rr][i][0] = *(const f32x4*)(resf + ro + 512 * i); h[rr][i][1] = *(const f32x4*)(resf + ro + 512 * i + 4); }
                else { const u32x4 r = *(const u32x4*)(hb + blk_off(row + rr * nw, 512 * i + 8 * lane, M_TOK)); h[rr][i][0] = (f32x4){bf_lo(r.x), bf_hi(r.x), bf_lo(r.y), bf_hi(r.y)}; h[rr][i][1] = (f32x4){bf_lo(r.z), bf_hi(r.z), bf_lo(r.w), bf_hi(r.w)}; } }
            if (!RESF32) { const float un = rs[row + rr * nw];
#pragma unroll
                for (int i = 0; i < 4; ++i) { h[rr][i][0] *= un; h[rr][i][1] *= un; } } }
#pragma unroll
        for (int rr = 0; rr < 2; ++rr) { const size_t ro = (size_t)(row + rr * nw) * DM + 8 * lane;
            f32x4 f[4][2]; float ss = 0.f;
#pragma unroll
            for (int i = 0; i < 4; ++i) { const u32x4 raw = fraw[rr][i];
                f[i][0] = (f32x4){bf_lo(raw.x), bf_hi(raw.x), bf_lo(raw.y), bf_hi(raw.y)}; f[i][1] = (f32x4){bf_lo(raw.z), bf_hi(raw.z), bf_lo(raw.w), bf_hi(raw.w)};
#pragma unroll
                for (int j = 0; j < 4; ++j) ss += f[i][0][j] * f[i][0][j] + f[i][1][j] * f[i][1][j]; }
            ss = wave_sum(ss);
            const float rsf = coef * rsqrtf(ss * (1.0f / DM) + EPS);
            float s2 = 0.f;
#pragma unroll
            for (int i = 0; i < 4; ++i) { const f32x4 g0 = *(const f32x4*)(gpost + 512 * i + 8 * lane), g1 = *(const f32x4*)(gpost + 512 * i + 8 * lane + 4);
                const f32x4 h0 = h[rr][i][0] + f[i][0] * rsf * g0, h1 = h[rr][i][1] + f[i][1] * rsf * g1;
                if (OUTF32) { *(f32x4*)(outf + ro + 512 * i) = h0; *(f32x4*)(outf + ro + 512 * i + 4) = h1; }
                else { h[rr][i][0] = h0; h[rr][i][1] = h1;
#pragma unroll
                    for (int j = 0; j < 4; ++j) s2 += h0[j] * h0[j] + h1[j] * h1[j]; } }
            if (!OUTF32) { s2 = wave_sum(s2); const float ms = s2 * (1.0f / DM) + EPS, rstd = rsqrtf(ms);
                if (lane == 0) rs[row + rr * nw] = sqrtf(ms);
#pragma unroll
                for (int i = 0; i < 4; ++i) { const f32x4 h0 = h[rr][i][0] * rstd, h1 = h[rr][i][1] * rstd;
                    u32x4 w; w.x = pk_bf16(h0[0], h0[1]); w.y = pk_bf16(h0[2], h0[3]); w.z = pk_bf16(h1[0], h1[1]); w.w = pk_bf16(h1[2], h1[3]);
                    *(u32x4*)(hb + blk_off(row + rr * nw, 512 * i + 8 * lane, M_TOK)) = w; } }
        }
    }
}

__device__ __forceinline__ void unpack8(const u32x4 raw, float (&x)[8]) {
    x[0] = bf_lo(raw.x); x[1] = bf_hi(raw.x); x[2] = bf_lo(raw.y); x[3] = bf_hi(raw.y); x[4] = bf_lo(raw.z); x[5] = bf_hi(raw.z); x[6] = bf_lo(raw.w); x[7] = bf_hi(raw.w);
}

#define LDS_BARRIER() do { asm volatile("s_waitcnt lgkmcnt(0)" ::: "memory"); __builtin_amdgcn_s_barrier(); asm volatile("" ::: "memory"); } while (0)
constexpr int LC = 256, XP = 136, FP2 = 36, GP = 40;
__device__ void phase_lru(const Params& p, unsigned char* ldsg) {
    const bf16_t* __restrict__ Z = (const bf16_t*)(p.ws + WS_HB);
    bf16_t* __restrict__ Y = (bf16_t*)(p.ws + WS_Y);
    const bf16_t* WrT = (const bf16_t*)(p.ws + WS_WR); const bf16_t* WiT = (const bf16_t*)(p.ws + WS_WI);
    bf16_t* XCb = (bf16_t*)ldsg;
    bf16_t* Yt = XCb;
    float* XCf = (float*)(ldsg + LC * XP * 2);
    bf16_t* Gt = (bf16_t*)(ldsg + LC * XP * 2 + LC * FP2 * 4);
    float* EX = (float*)(ldsg + LC * XP * 2 + LC * FP2 * 4 + LC * GP * 2);
    float* CW = EX + 256;
    int tid = threadIdx.x; asm volatile("" : "+v"(tid));
    const int lane = tid & 63, wid = tid >> 6, fr = lane & 15, fq = lane >> 4;
    const int nf = wid & 1, mg = wid >> 1;
    const int g = tid & 15, tl = tid >> 4;
    const int gtok = tid >> 2, gcg = tid & 3;
    const int vb = (gridDim.x % 8 == 0) ? (int)(blockIdx.x % 8) * (int)(gridDim.x / 8) + (int)(blockIdx.x / 8) : (int)blockIdx.x;
    for (int it = vb; it < 256; it += gridDim.x) {
        const int q = it & 3, h = (it >> 2) & 7, b = it >> 5;
        for (int i = tid; i < 640; i += 512) CW[i] = (i < 512) ? p.in[8][(i >> 7) * 1024 + h * 128 + (i & 127)] : p.in[9][h * 128 + (i & 127)];
        const int chq = 16 * nf + fr, ch = h * 128 + 32 * q + chq;
        const float br = p.in[11][ch], bi = p.in[13][ch];
        const float nl = -p.in[14][ch];
        const float c1 = -8.0f * (fmaxf(nl, 0.f) + log1pf(expf(-fabsf(nl))));
        const bool own = (g >> 2) == q;
        LDS_BARRIER();
        const bf16_t* zx = Z + (size_t)b * SEQ * DIN + h * 128 + 8 * g;
        const bf16_t* zg = Z + (size_t)b * SEQ * DIN + 1024 + h * 128 + 32 * q + 8 * gcg;
        float carry = 0.f;
        u32x4 raw[11], graw[2];
        const bf16_t* zp = zx + (ptrdiff_t)(8 * tl - 3) * DIN;
        const bf16_t* gp = zg + (size_t)gtok * DIN;
#pragma unroll
        for (int j = 0; j < 11; ++j) { raw[j] = (u32x4){0u, 0u, 0u, 0u}; if (8 * tl - 3 + j >= 0) raw[j] = *(const u32x4*)(zp + j * DIN); }
#pragma unroll
        for (int jj = 0; jj < 2; ++jj) graw[jj] = *(const u32x4*)(gp + jj * 128 * DIN);
        for (int c = 0; c < SEQ / LC; ++c) {
            const int t0 = c * LC;
            {
                f32x4 cwv[5][2];
#pragma unroll
                for (int k = 0; k < 5; ++k) { cwv[k][0] = *(const f32x4*)(CW + k * 128 + 8 * g); cwv[k][1] = *(const f32x4*)(CW + k * 128 + 8 * g + 4); }
#pragma unroll
                for (int hf = 0; hf < 2; ++hf) {
                    float xc[4][8];
#pragma unroll
                    for (int o = 0; o < 4; ++o)
#pragma unroll
                        for (int e = 0; e < 8; ++e) xc[o][e] = cwv[4][e >> 2][e & 3];
#pragma unroll
                    for (int jr = 0; jr < 7; ++jr) { float x[8]; unpack8(raw[4 * hf + jr], x);
#pragma unroll
                        for (int k = 0; k < 4; ++k) { const int o = jr - k; if (o >= 0 && o < 4) {
#pragma unroll
                            for (int e = 0; e < 8; ++e) xc[o][e] += cwv[k][e >> 2][e & 3] * x[e]; } } }
#pragma unroll
                    for (int o = 0; o < 4; ++o) { const int tt = 8 * tl + 4 * hf + o;
                        u32x4 w; w.x = pk_bf16(xc[o][0], xc[o][1]); w.y = pk_bf16(xc[o][2], xc[o][3]); w.z = pk_bf16(xc[o][4], xc[o][5]); w.w = pk_bf16(xc[o][6], xc[o][7]);
                        *(u32x4*)(XCb + tt * XP + 8 * g) = w;
                        if (own) { *(f32x4*)(XCf + tt * FP2 + 8 * (g & 3)) = (f32x4){xc[o][0], xc[o][1], xc[o][2], xc[o][3]}; *(f32x4*)(XCf + tt * FP2 + 8 * (g & 3) + 4) = (f32x4){xc[o][4], xc[o][5], xc[o][6], xc[o][7]}; } }
                    __builtin_amdgcn_sched_barrier(0);
                }
#pragma unroll
                for (int jj = 0; jj < 2; ++jj) *(u32x4*)(Gt + (gtok + 128 * jj) * GP + 8 * gcg) = graw[jj];
            }
            bf16x8 Br[4], Bi[4];
#pragma unroll
            for (int kk = 0; kk < 4; ++kk) { Br[kk] = *(const bf16x8*)(WrT + (ch * 128 + 32 * kk + 8 * fq)); Bi[kk] = *(const bf16x8*)(WiT + (ch * 128 + 32 * kk + 8 * fq)); }
            LDS_BARRIER();
            f32x4 ar[4], ai[4];
#pragma unroll
            for (int m = 0; m < 4; ++m) { ar[m] = (f32x4){0.f, 0.f, 0.f, 0.f}; ai[m] = (f32x4){0.f, 0.f, 0.f, 0.f};
#pragma unroll
                for (int kk = 0; kk < 4; ++kk) { const bf16x8 a = *(const bf16x8*)(XCb + (64 * mg + 16 * m + fr) * XP + 32 * kk + 8 * fq);
                    ar[m] = __builtin_amdgcn_mfma_f32_16x16x32_bf16(a, Br[kk], ar[m], 0, 0, 0); ai[m] = __builtin_amdgcn_mfma_f32_16x16x32_bf16(a, Bi[kk], ai[m], 0, 0, 0); } }
            float av[4][4], bv[4][4], Ap[4], Bp[4], At[4], Bt[4];
            float Aw = 1.f, Bw = 0.f;
#pragma unroll
            for (int m = 0; m < 4; ++m) {
#pragma unroll
                for (int e2 = 0; e2 < 2; ++e2) {
                    const int tt = 64 * mg + 16 * m + 4 * fq + 2 * e2;
                    const f32x2 pr = (f32x2){ar[m][2 * e2], ar[m][2 * e2 + 1]} + br, pi = (f32x2){ai[m][2 * e2], ai[m][2 * e2 + 1]} + bi;
                    const f32x2 xr = pr * -1.4426950409f, xi = pi * -1.4426950409f;
                    f32x2 er, ei; er.x = __builtin_amdgcn_exp2f(xr.x); er.y = __builtin_amdgcn_exp2f(xr.y); ei.x = __builtin_amdgcn_exp2f(xi.x); ei.y = __builtin_amdgcn_exp2f(xi.y);
                    const f32x2 dr = er + 1.0f, di = ei + 1.0f;
                    f32x2 r, ig; r.x = __builtin_amdgcn_rcpf(dr.x); r.y = __builtin_amdgcn_rcpf(dr.y); ig.x = __builtin_amdgcn_rcpf(di.x); ig.y = __builtin_amdgcn_rcpf(di.y);
                    const f32x2 xcv = (f32x2){XCf[tt * FP2 + chq], XCf[(tt + 1) * FP2 + chq]};
                    const f32x2 l2 = r * (c1 * 1.4426950409f);
                    f32x2 a; a.x = __builtin_amdgcn_exp2f(l2.x); a.y = __builtin_amdgcn_exp2f(l2.y);
                    const f32x2 om = 1.0f - a * a;
                    f32x2 sq; sq.x = __builtin_amdgcn_sqrtf(om.x); sq.y = __builtin_amdgcn_sqrtf(om.y);
                    const f32x2 bb = sq * ig * xcv;
                    av[m][2 * e2] = a.x; av[m][2 * e2 + 1] = a.y; bv[m][2 * e2] = bb.x; bv[m][2 * e2 + 1] = bb.y; }
                float A = 1.f, B = 0.f;
#pragma unroll
                for (int e = 0; e < 4; ++e) { B = av[m][e] * B + bv[m][e]; A = av[m][e] * A; }
                { const float A1 = __shfl_up(A, 16), B1 = __shfl_up(B, 16); if (fq >= 1) { B = A * B1 + B; A = A * A1; } }
                { const float A2 = __shfl_up(A, 32), B2 = __shfl_up(B, 32); if (fq >= 2) { B = A * B2 + B; A = A * A2; } }
                Ap[m] = __shfl_up(A, 16); Bp[m] = __shfl_up(B, 16); if (fq == 0) { Ap[m] = 1.f; Bp[m] = 0.f; }
                At[m] = __shfl(A, 48 + fr); Bt[m] = __shfl(B, 48 + fr);
                Bw = At[m] * Bw + Bt[m]; Aw = At[m] * Aw;
            }
            if (fq == 0) { EX[((mg * 2 + nf) * 16 + fr) * 2] = Aw; EX[((mg * 2 + nf) * 16 + fr) * 2 + 1] = Bw; }
            if (c + 1 < SEQ / LC) {
                zp += LC * DIN; gp += LC * DIN;
                asm volatile("" : "+v"(zp), "+v"(gp));
#pragma unroll
                for (int j = 0; j < 11; ++j) raw[j] = *(const u32x4*)(zp + j * DIN);
#pragma unroll
                for (int jj = 0; jj < 2; ++jj) graw[jj] = *(const u32x4*)(gp + jj * 128 * DIN);
            }
            LDS_BARRIER();
            float cin = carry, cnext = carry;
#pragma unroll
            for (int mm = 0; mm < 4; ++mm) { const float A = EX[((mm * 2 + nf) * 16 + fr) * 2], B = EX[((mm * 2 + nf) * 16 + fr) * 2 + 1]; cnext = A * cnext + B; if (mm < mg) cin = A * cin + B; }
            carry = cnext;
            float cm = cin;
#pragma unroll
            for (int m = 0; m < 4; ++m) {
                float hs = Ap[m] * cm + Bp[m];
#pragma unroll
                for (int e = 0; e < 4; ++e) { const int tt = 64 * mg + 16 * m + 4 * fq + e;
                    hs = av[m][e] * hs + bv[m][e];
                    const float gt = bf2f(Gt[tt * GP + chq]);
                    const float u2 = 1.5957691216f * (gt + 0.044715f * gt * gt * gt);
                    const float y = hs * gt * sigmoidf_fast(u2);
                    Yt[tt * GP + chq] = (bf16_t)(pk_bf16(y, 0.f) & 0xffffu); }
                cm = At[m] * cm + Bt[m];
            }
            LDS_BARRIER();
#pragma unroll
            for (int jj = 0; jj < 2; ++jj) *(u32x4*)(Y + blk_off(b * SEQ + t0 + gtok + 128 * jj, h * 128 + 32 * q + 8 * gcg, M_TOK)) = *(const u32x4*)(Yt + (gtok + 128 * jj) * GP + 8 * gcg);
            LDS_BARRIER();
        }
    }
}

__device__ void phase_shortconv(const Params& p) {
    const bf16_t* __restrict__ Z = (const bf16_t*)(p.ws + WS_HB);
    bf16_t* __restrict__ Y = (bf16_t*)(p.ws + WS_Y);
    const float* __restrict__ w = p.in[15];
    for (int item = blockIdx.x * 512 + threadIdx.x; item < (M_TOK / 16) * 128; item += gridDim.x * 512) {
        const int cgp = item & 127, run = item >> 7, t0 = run * 16;
        float w0[8], w1[8], w2[8], p1[8], p2[8];
#pragma unroll
        for (int j = 0; j < 8; ++j) { w0[j] = w[8 * cgp + j]; w1[j] = w[1024 + 8 * cgp + j]; w2[j] = w[2048 + 8 * cgp + j]; p1[j] = 0.f; p2[j] = 0.f; }
        if ((t0 & (SEQ - 1)) != 0) {
            float c[8], x[8];
            const bf16_t* b1 = Z + (size_t)(t0 - 1) * DIN + 8 * cgp; unpack8(*(const u32x4*)(b1 + 3072), c); unpack8(*(const u32x4*)(b1 + 4096), x);
#pragma unroll
            for (int j = 0; j < 8; ++j) p1[j] = c[j] * x[j];
            const bf16_t* b2 = Z + (size_t)(t0 - 2) * DIN + 8 * cgp; unpack8(*(const u32x4*)(b2 + 3072), c); unpack8(*(const u32x4*)(b2 + 4096), x);
#pragma unroll
            for (int j = 0; j < 8; ++j) p2[j] = c[j] * x[j];
        }
#pragma unroll 4
        for (int tt = 0; tt < 16; ++tt) {
            const bf16_t* base = Z + (size_t)(t0 + tt) * DIN + 8 * cgp;
            float bb[8], c[8], x[8], y[8];
            unpack8(*(const u32x4*)(base + 2048), bb); unpack8(*(const u32x4*)(base + 3072), c); unpack8(*(const u32x4*)(base + 4096), x);
#pragma unroll
            for (int j = 0; j < 8; ++j) { const float p0 = c[j] * x[j]; y[j] = bb[j] * (w0[j] * p2[j] + w1[j] * p1[j] + w2[j] * p0); p2[j] = p1[j]; p1[j] = p0; }
            u32x4 o; o.x = pk_bf16(y[0], y[1]); o.y = pk_bf16(y[2], y[3]); o.z = pk_bf16(y[4], y[5]); o.w = pk_bf16(y[6], y[7]);
            *(u32x4*)(Y + blk_off(t0 + tt, 1024 + 8 * cgp, M_TOK)) = o;
        }
    }
}


#define XB_TMO      128
#define XB_XCNT(j)  (256  + 64 * (j))
#define XB_XSUB(j)  (1280 + 64 * (j))
#define XB_XGEN(j)  (2304 + 64 * (j))
#define XB_TOP      3328
#define XB_TOPGEN   3392
#define XCD_BAR_WORDS 3456
#define XB_SPIN_CAP (1u << 18)
__device__ __forceinline__ unsigned xb_ld(unsigned* p)              { return __hip_atomic_load(p, __ATOMIC_RELAXED, __HIP_MEMORY_SCOPE_AGENT); }
__device__ __forceinline__ unsigned xb_add(unsigned* p, unsigned v) { return __hip_atomic_fetch_add(p, v, __ATOMIC_RELAXED, __HIP_MEMORY_SCOPE_AGENT); }
__device__ __forceinline__ unsigned xb_xcc_id() { return (unsigned)__builtin_amdgcn_s_getreg((3 << 11) | 20) & 0xFu; }
#define XB_SPIN(cond, bar) do { unsigned _sp = 0; while (cond) {   \
    if ((++_sp & 255u) == 0u) { if (xb_ld(&(bar)[XB_TMO])) break; if (_sp > XB_SPIN_CAP) { atomicAdd(&(bar)[XB_TMO], 1u); break; } } } } while (0)
struct XcdBarrier { unsigned* bar; unsigned x; volatile LAS unsigned* st; };
__device__ __forceinline__ XcdBarrier xcd_barrier_post(unsigned* bar, volatile LAS unsigned* st) {
    XcdBarrier b; b.bar = bar; b.x = xb_xcc_id(); b.st = st;
    if (threadIdx.x == 0) (void)xb_add(&bar[XB_XCNT(b.x)], 1u);
    return b;
}
__device__ __forceinline__ void xcd_barrier_complete(unsigned* bar, unsigned x, unsigned& nloc, unsigned& nx) {
    const unsigned G = gridDim.x * gridDim.y * gridDim.z;
    unsigned sum, cnt, mine, sp = 0u;
    for (;;) {
        sum = 0u; cnt = 0u; mine = 0u;
#pragma unroll
        for (unsigned j = 0; j < 16; ++j) { const unsigned c = xb_ld(&bar[XB_XCNT(j)]); sum += c; cnt += (c > 0u) ? 1u : 0u; mine = (j == x) ? c : mine; }
        if (sum == G) break;
        __builtin_amdgcn_s_sleep(1);
        if ((++sp & 255u) == 0u) { if (xb_ld(&bar[XB_TMO])) break; if (sp > XB_SPIN_CAP) { atomicAdd(&bar[XB_TMO], 1u); break; } }
    }
    nloc = mine > 0u ? mine : 1u; nx = cnt > 0u ? cnt : 1u;
}
__device__ __forceinline__ void xcd_barrier(const XcdBarrier& b) {
    asm volatile("s_waitcnt vmcnt(0)" ::: "memory");
    __syncthreads();
    if (threadIdx.x == 0) {
        unsigned* bar = b.bar;
        __builtin_amdgcn_s_waitcnt(0);
        unsigned nloc = b.st[0], nx = b.st[1];
        if (nloc == 0u) { xcd_barrier_complete(bar, b.x, nloc, nx); b.st[0] = nloc; b.st[1] = nx; }
        const unsigned old = xb_add(&bar[XB_XSUB(b.x)], 1u);
        const unsigned gen = old / nloc;
        if (old + 1u == (gen + 1u) * nloc) {
            __builtin_amdgcn_fence(__ATOMIC_RELEASE, "agent");
            asm volatile("s_waitcnt vmcnt(0)" ::: "memory");
            const unsigned og = xb_add(&bar[XB_TOP], 1u);
            const unsigned tg = og / nx;
            if (og + 1u == (tg + 1u) * nx) xb_add(&bar[XB_TOPGEN], 1u);
            else XB_SPIN(xb_ld(&bar[XB_TOPGEN]) == tg, bar);
            __builtin_amdgcn_fence(__ATOMIC_ACQUIRE, "agent");
            xb_add(&bar[XB_XGEN(b.x)], 1u);
            asm volatile("s_waitcnt vmcnt(0)" ::: "memory");
        } else {
            XB_SPIN(xb_ld(&bar[XB_XGEN(b.x)]) == gen, bar);
            __builtin_amdgcn_fence(__ATOMIC_ACQUIRE, "agent");
            asm volatile("s_waitcnt vmcnt(0)" ::: "memory");
        }
    }
    __syncthreads();
}

__global__ void __launch_bounds__(512, 2) mega_fwd(Params p) {
    extern __shared__ __attribute__((aligned(16))) unsigned char lds[];
    cg::grid_group grid = cg::this_grid();
    LAS unsigned char* lds3 = (LAS unsigned char*)lds;
    const int G = gridDim.x, c = blockIdx.x;
    if (threadIdx.x < 4) ((LAS unsigned*)(lds3 + 131072))[threadIdx.x] = 0u;
    __syncthreads();
    const XcdBarrier xbar = xcd_barrier_post((unsigned*)(p.ws + WS_BAR), (volatile LAS unsigned*)(lds3 + 131072));
    bf16_t* XB = (bf16_t*)(p.ws + WS_A1); bf16_t* HB = (bf16_t*)(p.ws + WS_HB); bf16_t* Fb = (bf16_t*)(p.ws + WS_F); bf16_t* Yb = (bf16_t*)(p.ws + WS_Y);
    float* RS = (float*)(p.ws + WS_RS);

    phase_convert<false>(p, lds, 0, 2112);
    phase_prenorm(p.in[0], XB, RS);
    if (p.ws == nullptr) grid.sync();
    xcd_barrier(xbar);
    { pg8::Gemm g{XB, (const bf16_t*)(p.ws + WS_WGU1), M_TOK, 2 * DFF, DM}; pg8::StaticOrder S; S.init(M_TOK, 2 * DFF, G, c); pg8::EpiSwiGLU E{HB, M_TOK}; pg8::gemm_phase(lds3, g, S, E); }
    xcd_barrier(xbar);
    phase_convert<true>(p, lds, 2112, 5120);
    { pg8::Gemm g{HB, (const bf16_t*)(p.ws + WS_WD1), M_TOK, DM, DFF}; pg8::StaticOrder S; S.init(M_TOK, DM, G, c, 4); pg8::EpiBf16 E{Fb, DM}; pg8::gemm_phase(lds3, g, S, E); }
    xcd_barrier(xbar);
    phase_norm<false, false>(Fb, nullptr, XB, nullptr, RS, p.in[5], 0.5f);
    xcd_barrier(xbar);
    { pg8::Gemm g{XB, (const bf16_t*)(p.ws + WS_WIN), M_TOK, DIN, DM}; pg8::StaticOrder S; S.init(M_TOK, DIN, G, c, 16); pg8::EpiBf16 E{HB, DIN}; pg8::gemm_phase(lds3, g, S, E); }
    xcd_barrier(xbar);
    if (__builtin_amdgcn_readfirstlane(threadIdx.x) >= 256) __builtin_amdgcn_s_setprio(1);
    phase_lru(p, lds);
    __builtin_amdgcn_s_setprio(0);
    phase_shortconv(p);
    xcd_barrier(xbar);
    { pg8::Gemm g{Yb, (const bf16_t*)(p.ws + WS_WOUT), M_TOK, DM, DM}; pg8::StaticOrder S; S.init(M_TOK, DM, G, c, 4); pg8::EpiBf16 E{Fb, DM}; pg8::gemm_phase(lds3, g, S, E); }
    xcd_barrier(xbar);
    phase_norm<false, false>(Fb, nullptr, XB, nullptr, RS, p.in[17], 1.0f);
    xcd_barrier(xbar);
    { pg8::Gemm g{XB, (const bf16_t*)(p.ws + WS_WGU2), M_TOK, 2 * DFF, DM}; pg8::StaticOrder S; S.init(M_TOK, 2 * DFF, G, c); pg8::EpiSwiGLU E{HB, M_TOK}; pg8::gemm_phase(lds3, g, S, E); }
    xcd_barrier(xbar);
    { pg8::Gemm g{HB, (const bf16_t*)(p.ws + WS_WD2), M_TOK, DM, DFF}; pg8::StaticOrder S; S.init(M_TOK, DM, G, c, 4); pg8::EpiBf16 E{Fb, DM}; pg8::gemm_phase(lds3, g, S, E); }
    xcd_barrier(xbar);
    phase_norm<false, true>(Fb, nullptr, XB, p.out, RS, p.in[22], 0.5f);
}

extern "C" void kernel_launch(void* const* d_in, const int* in_sizes, int n_in, void* d_out, int out_size, void* d_ws, size_t ws_size, hipStream_t stream) {
    static int grid_blocks = 0;
    if (!grid_blocks) {
        int dev = 0, cus = 0, per_cu = 0;
        hipGetDevice(&dev);
        hipDeviceGetAttribute(&cus, hipDeviceAttributeMultiprocessorCount, dev);
        if (hipFuncSetAttribute((const void*)mega_fwd, hipFuncAttributeMaxDynamicSharedMemorySize, LDS_BYTES) != hipSuccess) fprintf(stderr, "hipFuncSetAttribute failed\n");
        if (hipOccupancyMaxActiveBlocksPerMultiprocessor(&per_cu, (const void*)mega_fwd, 512, LDS_BYTES) != hipSuccess || per_cu < 1) { fprintf(stderr, "occupancy query gave %d\n", per_cu); per_cu = 1; }
        (void)hipGetLastError();
        if (cus <= 0) cus = 256;
        grid_blocks = cus * per_cu;
        if (ws_size < WS_END) fprintf(stderr, "workspace too small: %zu < %zu\n", ws_size, (size_t)WS_END);
    }
    Params p{};
    for (int i = 0; i < 23; ++i) p.in[i] = (const float*)d_in[i];
    p.out = (float*)d_out; p.ws = (unsigned char*)d_ws;
    if (hipMemsetAsync((char*)d_ws + WS_BAR, 0, 16384, stream) != hipSuccess) fprintf(stderr, "memset failed\n");
    void* args[] = {&p};
    hipError_t e = hipLaunchCooperativeKernel((const void*)mega_fwd, dim3(grid_blocks), dim3(512), args, LDS_BYTES, stream);
    if (e != hipSuccess) fprintf(stderr, "cooperative launch failed: %s (grid %d)\n", hipGetErrorString(e), grid_blocks);
}
```

```cpp
#include <hip/hip_runtime.h>
#include <hip/hip_cooperative_groups.h>
#include <cstdio>
namespace cg = cooperative_groups;

#define LAS __attribute__((address_space(3)))
typedef unsigned short bf16_t;
typedef short bf16x8 __attribute__((ext_vector_type(8)));
typedef float f32x4 __attribute__((ext_vector_type(4)));
typedef unsigned u32x4 __attribute__((ext_vector_type(4)));
typedef unsigned u32x2 __attribute__((ext_vector_type(2)));
typedef float f32x2 __attribute__((ext_vector_type(2)));

constexpr int M_TOK = 32768, DM = 2048, DFF = 5632, DIN = 5120, SEQ = 4096;
constexpr float EPS = 1e-6f;
constexpr int LDS_BYTES = 131072 + 16;

constexpr size_t SZ_WGU = (size_t)2 * DFF * DM * 2, SZ_WD = (size_t)DM * DFF * 2, SZ_WIN = (size_t)DIN * DM * 2, SZ_WOUT = (size_t)DM * DM * 2;
constexpr size_t WS_WGU1 = 0, WS_WD1 = WS_WGU1 + SZ_WGU, WS_WIN = WS_WD1 + SZ_WD, WS_WOUT = WS_WIN + SZ_WIN, WS_WGU2 = WS_WOUT + SZ_WOUT, WS_WD2 = WS_WGU2 + SZ_WGU;
constexpr size_t WS_WR = WS_WD2 + SZ_WD, WS_WI = WS_WR + 262144, WS_AGG = WS_WI + 262144, WS_BAR = WS_AGG + 524288;
constexpr size_t WS_RS = WS_AGG + 786432;
constexpr size_t WS_A1 = WS_AGG + 1048576, WS_HB = WS_A1 + (size_t)M_TOK * DM * 2, WS_F = WS_HB + (size_t)M_TOK * DFF * 2, WS_Y = WS_F + (size_t)M_TOK * DM * 2, WS_END = WS_Y + (size_t)M_TOK * DM * 2;

struct Params { const float* in[23]; float* out; unsigned char* ws; };

__device__ __forceinline__ unsigned pk_bf16(float lo, float hi) { unsigned r; asm("v_cvt_pk_bf16_f32 %0, %1, %2" : "=v"(r) : "v"(lo), "v"(hi)); return r; }
__device__ __forceinline__ float bf_lo(unsigned w) { return __uint_as_float(w << 16); }
__device__ __forceinline__ float bf_hi(unsigned w) { return __uint_as_float(w & 0xffff0000u); }
__device__ __forceinline__ float bf2f(bf16_t h) { return __uint_as_float(((unsigned)h) << 16); }
__device__ __forceinline__ float wave_sum(float v) {
#pragma unroll
    for (int o = 32; o >= 1; o >>= 1) v += __shfl_xor(v, o);
    return v;
}
__device__ __forceinline__ size_t blk_off(int row, int col, int nrows) { return ((size_t)(col >> 6) * nrows + row) * 64 + (col & 63); }
__device__ __forceinline__ float sigmoidf_fast(float v) { return __builtin_amdgcn_rcpf(1.0f + __expf(-v)); }

namespace pg8 {
constexpr int BM = 256, BK = 64, HALF = 128, HTB = HALF * BK * 2, STAGE_BYTES = 8 * HTB, NXCD = 8, WGM = 8;
__device__ __forceinline__ int lds_byte(int r, int c) { const int st = (r >> 4) * 2 + (c >> 5), rr = r & 15, cc = c & 31, ob = rr * 64 + cc * 2; return st * 1024 + (ob ^ (((ob >> 9) & 1) << 5)); }
__device__ __forceinline__ void stage_rc(int b, int& R, int& C) { const int st = b / 1024, sb = b % 1024, swz = sb ^ (((sb >> 9) & 1) << 5); R = (st >> 1) * 16 + swz / 64; C = (st & 1) * 32 + (swz % 64) / 2; }
__device__ __forceinline__ int perm32(int rho) { const int n = rho >> 4, i = rho & 15; return 8 * (i >> 2) + 4 * n + (i & 3); }

struct Unit { int pm, pn; };
struct Gemm { const bf16_t* A; const bf16_t* Bt; int M, N, K; };

struct StaticOrder {
    int nM, nN, nwg, G, c, wgm;
    __device__ void init(int M, int N, int G_, int c_, int wgm_ = WGM) { nM = M / BM; nN = N / BM; nwg = nM * nN; G = G_; c = c_; wgm = wgm_; }
    __device__ bool next(int i, Unit& u) const {
        const long L = (long)i * G + c; if (L >= nwg) return false;
        int wgid = (int)L; { const int q = nwg / NXCD, r = nwg % NXCD, xcd = wgid % NXCD, off = wgid / NXCD; wgid = (xcd < r ? xcd * (q + 1) : r * (q + 1) + (xcd - r) * q) + off; }
        const int nig = wgm * nN, gid = wgid / nig, fm = gid * wgm, gsz = (nM - fm) < wgm ? (nM - fm) : wgm;
        u.pm = fm + ((wgid % nig) % gsz); u.pn = (wgid % nig) / gsz; return true;
    }
};

struct EpiBf16 {
    static constexpr bool PERM = true;
    bf16_t* O; int ldc;
    __device__ __forceinline__ void operator()(const f32x4 (&acc)[2][2][4][2], const Unit& u, int wr, int wc, int fr, int fq) const {
        const int row0 = u.pm * BM + wr * 64 + fr; const int col0 = u.pn * BM + wc * 32 + 8 * fq;
#pragma unroll
        for (int ai = 0; ai < 2; ++ai)
#pragma unroll
            for (int m = 0; m < 4; ++m) { bf16_t* rowp = O + (size_t)(row0 + ai * HALF + m * 16) * ldc + col0;
#pragma unroll
                for (int bj = 0; bj < 2; ++bj) { const f32x4 v0 = acc[ai][bj][m][0], v1 = acc[ai][bj][m][1];
                    u32x4 w; w.x = pk_bf16(v0[0], v0[1]); w.y = pk_bf16(v0[2], v0[3]); w.z = pk_bf16(v1[0], v1[1]); w.w = pk_bf16(v1[2], v1[3]);
                    *(u32x4*)(rowp + bj * HALF) = w; } }
    }
};
struct EpiSwiGLU {
    static constexpr bool PERM = false;
    bf16_t* O; int nrows;
    __device__ __forceinline__ void operator()(const f32x4 (&acc)[2][2][4][2], const Unit& u, int wr, int wc, int fr, int fq) const {
        const int row0 = u.pm * BM + wr * 64 + fr; const int col0 = u.pn * HALF + wc * 32 + 8 * fq;
#pragma unroll
        for (int ai = 0; ai < 2; ++ai)
#pragma unroll
            for (int m = 0; m < 4; ++m) { bf16_t* rowp = O + blk_off(row0 + ai * HALF + m * 16, col0, nrows);
                float v[8];
#pragma unroll
                for (int bj = 0; bj < 2; ++bj)
#pragma unroll
                    for (int j = 0; j < 4; ++j) { const float g = acc[ai][bj][m][0][j], up = acc[ai][bj][m][1][j]; v[bj * 4 + j] = g * sigmoidf_fast(g) * up; }
                u32x4 w; w.x = pk_bf16(v[0], v[1]); w.y = pk_bf16(v[2], v[3]); w.z = pk_bf16(v[4], v[5]); w.w = pk_bf16(v[6], v[7]);
                *(u32x4*)rowp = w; }
    }
};

template <class Epi>
__device__ __forceinline__ void gemm_phase(LAS unsigned char* lds, const Gemm g, const StaticOrder& S, const Epi& E) {
    int tid = threadIdx.x; asm volatile("" : "+v"(tid));
    const int wid = __builtin_amdgcn_readfirstlane(tid >> 6), lane = tid & 63, wr = wid >> 2, wc = wid & 3, fr = lane & 15, fq = lane >> 4;
    const int K = g.K, nt = K / BK;
    unsigned voffA[2], voffB[2];
#pragma unroll
    for (int i = 0; i < 2; ++i) { int R, C; stage_rc(tid * 16 + i * 8192, R, C); const int Rb = Epi::PERM ? ((R & ~31) + perm32(R & 31)) : R;
        voffA[i] = (unsigned)(R * BK + C) * 2u; voffB[i] = (unsigned)(Rb * BK + C) * 2u; }
    const size_t kstepA = (size_t)g.M * BK * 2, kstepB = (size_t)g.N * BK * 2;
    const size_t hstep = (size_t)HALF * BK * 2;
    const size_t tstep = 2 * hstep;
    const unsigned ldsw = (unsigned)wid * 1024u;
    const int aoff = lds_byte(wr * 64 + fr, fq * 8), boff = lds_byte(wc * 32 + fr, fq * 8);
#define PG8_SA(b, h) (((b) * 2 + (h)) * HTB)
#define PG8_SB(b, h) ((4 + (b) * 2 + (h)) * HTB)
#define PG8_STAGE(bufoff, gbase, voff) do { _Pragma("unroll") for (int _i = 0; _i < 2; ++_i) \
        __builtin_amdgcn_global_load_lds((const unsigned*)((const char*)(gbase) + (voff)[_i]), (LAS unsigned*)(lds + (bufoff) + ldsw + _i * 8192), 16, 0, 0); } while (0)
#define PG8_LDA(dst, b, h) do { _Pragma("unroll") for (int m = 0; m < 4; ++m) _Pragma("unroll") for (int k = 0; k < 2; ++k) dst[m][k] = *(const LAS bf16x8*)(lds + PG8_SA(b, h) + aoff + m * 2048 + k * 1024); } while (0)
#define PG8_LDB(dst, b, h) do { _Pragma("unroll") for (int n = 0; n < 2; ++n) _Pragma("unroll") for (int k = 0; k < 2; ++k) dst[n][k] = *(const LAS bf16x8*)(lds + PG8_SB(b, h) + boff + n * 2048 + k * 1024); } while (0)
#define PG8_MMA(ai, bj, At, Bt) do { __builtin_amdgcn_s_setprio(1); _Pragma("unroll") for (int m = 0; m < 4; ++m) _Pragma("unroll") for (int n = 0; n < 2; ++n) _Pragma("unroll") for (int k = 0; k < 2; ++k) \
        acc[ai][bj][m][n] = __builtin_amdgcn_mfma_f32_16x16x32_bf16(Bt[n][k], At[m][k], acc[ai][bj][m][n], 0, 0, 0); __builtin_amdgcn_s_setprio(0); } while (0)
#define PG8_WAIT_V(n) asm volatile("s_waitcnt vmcnt(" #n ")" ::: "memory")
#define PG8_WAIT_L(n) asm volatile("s_waitcnt lgkmcnt(" #n ")" ::: "memory")
#define PG8_BAR __builtin_amdgcn_s_barrier()
#define PG8_SCHED __builtin_amdgcn_sched_barrier(0)
    Unit cur, nxt; int ui = 0;
    if (!S.next(0, cur)) return;
    f32x4 acc[2][2][4][2];
#pragma unroll
    for (int a = 0; a < 2; ++a)
#pragma unroll
        for (int b = 0; b < 2; ++b)
#pragma unroll
            for (int m = 0; m < 4; ++m)
#pragma unroll
                for (int n = 0; n < 2; ++n) acc[a][b][m][n] = (f32x4){0.f, 0.f, 0.f, 0.f};
    bf16x8 At[4][2], B0[2][2], B1[2][2];
    const char* cA = (const char*)g.A + (size_t)cur.pm * tstep; const char* cB = (const char*)g.Bt + (size_t)cur.pn * tstep;
    PG8_STAGE(PG8_SB(0, 0), cB, voffB); PG8_STAGE(PG8_SA(0, 0), cA, voffA); PG8_STAGE(PG8_SB(0, 1), cB + hstep, voffB); PG8_STAGE(PG8_SA(0, 1), cA + hstep, voffA);
    if (wr == 1) PG8_BAR;
    PG8_WAIT_V(4); PG8_BAR;
    PG8_STAGE(PG8_SB(1, 0), cB + kstepB, voffB); PG8_STAGE(PG8_SA(1, 0), cA + kstepA, voffA); PG8_STAGE(PG8_SB(1, 1), cB + hstep + kstepB, voffB);
    PG8_WAIT_V(6); PG8_BAR;
    for (;;) {
        const bool has_next = S.next(ui + 1, nxt);
        const char* nA = has_next ? (const char*)g.A + (size_t)nxt.pm * tstep : cA; const char* nB = has_next ? (const char*)g.Bt + (size_t)nxt.pn * tstep : cB;
        for (int t = 0; t < nt; t += 2) {
            const bool last = (t == nt - 2);
            const char* a1 = cA + (size_t)(t + 1) * kstepA;
            const char* a2 = last ? nA : cA + (size_t)(t + 2) * kstepA; const char* b2 = last ? nB : cB + (size_t)(t + 2) * kstepB;
            const char* a3 = a2 + kstepA; const char* b3 = b2 + kstepB;
            PG8_LDB(B0, 0, 0); PG8_SCHED; PG8_LDA(At, 0, 0); PG8_STAGE(PG8_SA(1, 1), a1 + hstep, voffA);
            PG8_WAIT_L(8); PG8_BAR; PG8_WAIT_L(0); PG8_MMA(0, 0, At, B0); PG8_BAR; PG8_SCHED;
            PG8_LDB(B1, 0, 1); PG8_STAGE(PG8_SB(0, 0), b2, voffB);
            PG8_BAR; PG8_WAIT_L(0); PG8_MMA(0, 1, At, B1); PG8_BAR;
            PG8_LDA(At, 0, 1); PG8_STAGE(PG8_SA(0, 0), a2, voffA);
            PG8_BAR; PG8_WAIT_L(0); PG8_MMA(1, 0, At, B0); PG8_BAR; PG8_SCHED;
            PG8_STAGE(PG8_SB(0, 1), b2 + hstep, voffB);
            PG8_WAIT_V(6); PG8_BAR; PG8_MMA(1, 1, At, B1); PG8_BAR;
            PG8_LDB(B0, 1, 0); PG8_SCHED; PG8_LDA(At, 1, 0); PG8_STAGE(PG8_SA(0, 1), a2 + hstep, voffA);
            PG8_WAIT_L(8); PG8_BAR; PG8_WAIT_L(0); PG8_MMA(0, 0, At, B0); PG8_BAR; PG8_SCHED;
            PG8_LDB(B1, 1, 1); PG8_STAGE(PG8_SB(1, 0), b3, voffB);
            PG8_BAR; PG8_WAIT_L(0); PG8_MMA(0, 1, At, B1); PG8_BAR;
            PG8_LDA(At, 1, 1); PG8_STAGE(PG8_SA(1, 0), a3, voffA);
            PG8_BAR; PG8_WAIT_L(0); PG8_MMA(1, 0, At, B0); PG8_BAR; PG8_SCHED;
            PG8_STAGE(PG8_SB(1, 1), b3 + hstep, voffB);
            PG8_WAIT_V(6); PG8_BAR; PG8_MMA(1, 1, At, B1); PG8_BAR;
        }
        E(acc, cur, wr, wc, fr, fq);
        if (!has_next) break;
#pragma unroll
        for (int a = 0; a < 2; ++a)
#pragma unroll
            for (int b = 0; b < 2; ++b)
#pragma unroll
                for (int m = 0; m < 4; ++m)
#pragma unroll
                    for (int n = 0; n < 2; ++n) acc[a][b][m][n] = (f32x4){0.f, 0.f, 0.f, 0.f};
        cur = nxt; cA = nA; cB = nB; ++ui;
    }
    PG8_WAIT_V(0);
    if (wr == 0) PG8_BAR;
    PG8_BAR;
#undef PG8_SA
#undef PG8_SB
#undef PG8_STAGE
#undef PG8_LDA
#undef PG8_LDB
#undef PG8_MMA
#undef PG8_WAIT_V
#undef PG8_WAIT_L
#undef PG8_BAR
#undef PG8_SCHED
}
}

constexpr int CV_PITCH = 260;
struct CvTile { const float* s0; const float* gk; bf16_t* dst; long d1; int K, Nsrc, mode, lt; };
__device__ __forceinline__ void cv_desc(const Params& p, int gt, CvTile& t) {
    const float* s0; const float* s1 = nullptr; const float* gk = nullptr; size_t doff; int K, Nsrc, mode = 0, lt;
    if (gt < 1408)      { s0 = p.in[2]; s1 = p.in[3]; gk = p.in[1]; doff = WS_WGU1; K = DM; Nsrc = DFF; mode = 1; lt = gt; }
    else if (gt < 2112) { s0 = p.in[4]; doff = WS_WD1; K = DFF; Nsrc = DM; lt = gt - 1408; }
    else if (gt < 2752) { s0 = p.in[7]; gk = p.in[6]; doff = WS_WIN; K = DM; Nsrc = DIN; lt = gt - 2112; }
    else if (gt < 3008) { s0 = p.in[16]; doff = WS_WOUT; K = DM; Nsrc = DM; lt = gt - 2752; }
    else if (gt < 4416) { s0 = p.in[19]; s1 = p.in[20]; gk = p.in[18]; doff = WS_WGU2; K = DM; Nsrc = DFF; mode = 1; lt = gt - 3008; }
    else                { s0 = p.in[21]; doff = WS_WD2; K = DFF; Nsrc = DM; lt = gt - 4416; }
    t.s0 = s0; t.gk = gk; t.dst = (bf16_t*)(p.ws + doff); t.d1 = mode ? (long)(s1 - s0) : 0; t.K = K; t.Nsrc = Nsrc; t.mode = mode; t.lt = lt;
}
__device__ __forceinline__ void cv_load(const CvTile& t, f32x4 (&v)[8], float (&gs)[8]) {
    const int tid = threadIdx.x, nkt = t.K / 64, pn = t.lt / nkt, kt = t.lt % nkt;
#pragma unroll
    for (int i = 0; i < 8; ++i) {
        const int idx = tid + 512 * i, k = idx >> 6, c = (idx & 63) * 4;
        long off;
        if (t.mode) off = (long)(kt * 64 + k) * t.Nsrc + pn * 128 + (c & 127) + ((c & 128) ? t.d1 : 0);
        else off = (long)(kt * 64 + k) * t.Nsrc + pn * 256 + c;
        v[i] = *(const f32x4*)(t.s0 + off);
        gs[i] = t.gk ? t.gk[kt * 64 + k] : 1.0f;
    }
}
template <bool LRU_W>
__device__ __forceinline__ void phase_convert(const Params& p, unsigned char* ldsg, const int lo, const int hi) {
    bf16_t* T = (bf16_t*)ldsg;
    const int tid = threadIdx.x;
    int gt = lo + blockIdx.x;
    f32x4 v[8]; float gs[8];
    CvTile t; cv_desc(p, gt < hi ? gt : lo, t);
    if (gt < hi) cv_load(t, v, gs);
    for (; gt < hi; gt += gridDim.x) {
#pragma unroll
        for (int i = 0; i < 8; ++i) { const int idx = tid + 512 * i, k = idx >> 6, c = (idx & 63) * 4; const f32x4 x = v[i] * gs[i];
            u32x2 w; w.x = pk_bf16(x[0], x[1]); w.y = pk_bf16(x[2], x[3]); *(u32x2*)(T + k * CV_PITCH + c) = w; }
        __syncthreads();
        const CvTile cur = t;
        const int gn = gt + gridDim.x;
        if (gn < hi) { cv_desc(p, gn, t); cv_load(t, v, gs); }
        const int nkt = cur.K / 64, pn = cur.lt / nkt, kt = cur.lt % nkt, ndst = cur.mode ? 2 * cur.Nsrc : cur.Nsrc;
#pragma unroll
        for (int q = tid; q < 2048; q += 512) {
            const int r = q >> 3, kc = q & 7;
            int c = r;
            if (cur.mode) { const int bj = r >> 7, wc = (r >> 5) & 3, sgu = (r >> 4) & 1, fq = (r >> 2) & 3, e = r & 3; c = sgu * 128 + wc * 32 + fq * 8 + bj * 4 + e; }
            unsigned short x[8];
#pragma unroll
            for (int j = 0; j < 8; ++j) x[j] = T[(kc * 8 + j) * CV_PITCH + c];
            u32x4 o; o.x = x[0] | ((unsigned)x[1] << 16); o.y = x[2] | ((unsigned)x[3] << 16); o.z = x[4] | ((unsigned)x[5] << 16); o.w = x[6] | ((unsigned)x[7] << 16);
            *(u32x4*)(cur.dst + ((size_t)kt * ndst + (pn * 256 + r)) * 64 + kc * 8) = o;
        }
        __syncthreads();
    }
    bf16_t* WrT = (bf16_t*)(p.ws + WS_WR); bf16_t* WiT = (bf16_t*)(p.ws + WS_WI);
    if (LRU_W) for (int idx = blockIdx.x * 512 + threadIdx.x; idx < 131072; idx += gridDim.x * 512) {
        const int h = idx >> 14, e = (idx >> 7) & 127, d = idx & 127;
        WrT[idx] = (bf16_t)(pk_bf16(p.in[10][h * 16384 + d * 128 + e], 0.f) & 0xffffu);
        WiT[idx] = (bf16_t)(pk_bf16(p.in[12][h * 16384 + d * 128 + e], 0.f) & 0xffffu);
    }
}

__device__ void phase_prenorm(const float* __restrict__ x, bf16_t* __restrict__ xb, float* __restrict__ rs) {
    const int lane = threadIdx.x & 63, wid = threadIdx.x >> 6;
    const int nw = gridDim.x * 8;
    if ((M_TOK % (2 * nw)) != 0) return;
    for (int row = blockIdx.x * 8 + wid; row < M_TOK; row += 2 * nw) {
        f32x4 v[2][4][2]; float ss[2];
#pragma unroll
        for (int rr = 0; rr < 2; ++rr) { const float* xr = x + (size_t)(row + rr * nw) * DM + 8 * lane;
#pragma unroll
            for (int i = 0; i < 4; ++i) { v[rr][i][0] = *(const f32x4*)(xr + 512 * i); v[rr][i][1] = *(const f32x4*)(xr + 512 * i + 4); } }
#pragma unroll
        for (int rr = 0; rr < 2; ++rr) { float a = 0.f;
#pragma unroll
            for (int i = 0; i < 4; ++i)
#pragma unroll
                for (int j = 0; j < 4; ++j) a += v[rr][i][0][j] * v[rr][i][0][j] + v[rr][i][1][j] * v[rr][i][1][j];
            ss[rr] = wave_sum(a); }
#pragma unroll
        for (int rr = 0; rr < 2; ++rr) { bf16_t* ar = xb + blk_off(row + rr * nw, 8 * lane, M_TOK);
            const float ms = ss[rr] * (1.0f / DM) + EPS, rstd = rsqrtf(ms);
            if (lane == 0) rs[row + rr * nw] = sqrtf(ms);
#pragma unroll
            for (int i = 0; i < 4; ++i) { const f32x4 o0 = v[rr][i][0] * rstd, o1 = v[rr][i][1] * rstd;
                u32x4 w; w.x = pk_bf16(o0[0], o0[1]); w.y = pk_bf16(o0[2], o0[3]); w.z = pk_bf16(o1[0], o1[1]); w.w = pk_bf16(o1[2], o1[3]);
                *(u32x4*)(ar + (size_t)i * 8 * M_TOK * 64) = w; } }
    }
}

template <bool RESF32, bool OUTF32>
__device__ __forceinline__ void phase_norm(const bf16_t* __restrict__ F, const float* __restrict__ resf, bf16_t* hb, float* __restrict__ outf, float* __restrict__ rs, const float* __restrict__ gpost, float coef) {
    const int lane = threadIdx.x & 63, wid = threadIdx.x >> 6;
    const int nw = gridDim.x * 8;
    for (int row = blockIdx.x * 8 + wid; row < M_TOK; row += 2 * nw) {
        u32x4 fraw[2][4]; f32x4 h[2][4][2];
#pragma unroll
        for (int rr = 0; rr < 2; ++rr) { const size_t ro = (size_t)(row + rr * nw) * DM + 8 * lane;
#pragma unroll
            for (int i = 0; i < 4; ++i) { fraw[rr][i] = *(const u32x4*)(F + ro + 512 * i);
                if (RESF32) { h[rr][i][0] = *(const f32x4*)(resf + ro + 512 * i); h[rr][i][1] = *(const f32x4*)(resf + ro + 512 * i + 4); }
                else { const u32x4 r = *(const u32x4*)(hb + blk_off(row + rr * nw, 512 * i + 8 * lane, M_TOK)); h[rr][i][0] = (f32x4){bf_lo(r.x), bf_hi(r.x), bf_lo(r.y), bf_hi(r.y)}; h[rr][i][1] = (f32x4){bf_lo(r.z), bf_hi(r.z), bf_lo(r.w), bf_hi(r.w)}; } }
            if (!RESF32) { const float un = rs[row + rr * nw];
#pragma unroll
                for (int i = 0; i < 4; ++i) { h[rr][i][0] *= un; h[rr][i][1] *= un; } } }
#pragma unroll
        for (int rr = 0; rr < 2; ++rr) { const size_t ro = (size_t)(row + rr * nw) * DM + 8 * lane;
            f32x4 f[4][2]; float ss = 0.f;
#pragma unroll
            for (int i = 0; i < 4; ++i) { const u32x4 raw = fraw[rr][i];
                f[i][0] = (f32x4){bf_lo(raw.x), bf_hi(raw.x), bf_lo(raw.y), bf_hi(raw.y)}; f[i][1] = (f32x4){bf_lo(raw.z), bf_hi(raw.z), bf_lo(raw.w), bf_hi(raw.w)};
#pragma unroll
                for (int j = 0; j < 4; ++j) ss += f[i][0][j] * f[i][0][j] + f[i][1][j] * f[i][1][j]; }
            ss = wave_sum(ss);
            const float rsf = coef * rsqrtf(ss * (1.0f / DM) + EPS);
            float s2 = 0.f;
#pragma unroll
            for (int i = 0; i < 4; ++i) { const f32x4 g0 = *(const f32x4*)(gpost + 512 * i + 8 * lane), g1 = *(const f32x4*)(gpost + 512 * i + 8 * lane + 4);
                const f32x4 h0 = h[rr][i][0] + f[i][0] * rsf * g0, h1 = h[rr][i][1] + f[i][1] * rsf * g1;
                if (OUTF32) { *(f32x4*)(outf + ro + 512 * i) = h0; *(f32x4*)(outf + ro + 512 * i + 4) = h1; }
                else { h[rr][i][0] = h0; h[rr][i][1] = h1;
#pragma unroll
                    for (int j = 0; j < 4; ++j) s2 += h0[j] * h0[j] + h1[j] * h1[j]; } }
            if (!OUTF32) { s2 = wave_sum(s2); const float ms = s2 * (1.0f / DM) + EPS, rstd = rsqrtf(ms);
                if (lane == 0) rs[row + rr * nw] = sqrtf(ms);
#pragma unroll
                for (int i = 0; i < 4; ++i) { const f32x4 h0 = h[rr][i][0] * rstd, h1 = h[rr][i][1] * rstd;
                    u32x4 w; w.x = pk_bf16(h0[0], h0[1]); w.y = pk_bf16(h0[2], h0[3]); w.z = pk_bf16(h1[0], h1[1]); w.w = pk_bf16(h1[2], h1[3]);
                    *(u32x4*)(hb + blk_off(row + rr * nw, 512 * i + 8 * lane, M_TOK)) = w; } }
        }
    }
}

__device__ __forceinline__ void unpack8(const u32x4 raw, float (&x)[8]) {
    x[0] = bf_lo(raw.x); x[1] = bf_hi(raw.x); x[2] = bf_lo(raw.y); x[3] = bf_hi(raw.y); x[4] = bf_lo(raw.z); x[5] = bf_hi(raw.z); x[6] = bf_lo(raw.w); x[7] = bf_hi(raw.w);
}

#define LDS_BARRIER() do { asm volatile("s_waitcnt lgkmcnt(0)" ::: "memory"); __builtin_amdgcn_s_barrier(); asm volatile("" ::: "memory"); } while (0)
constexpr int LC = 256, XP = 136, FP2 = 36, GP = 40;
__device__ void phase_lru(const Params& p, unsigned char* ldsg) {
    const bf16_t* __restrict__ Z = (const bf16_t*)(p.ws + WS_HB);
    bf16_t* __restrict__ Y = (bf16_t*)(p.ws + WS_Y);
    const bf16_t* WrT = (const bf16_t*)(p.ws + WS_WR); const bf16_t* WiT = (const bf16_t*)(p.ws + WS_WI);
    bf16_t* XCb = (bf16_t*)ldsg;
    bf16_t* Yt = XCb;
    float* XCf = (float*)(ldsg + LC * XP * 2);
    bf16_t* Gt = (bf16_t*)(ldsg + LC * XP * 2 + LC * FP2 * 4);
    float* EX = (float*)(ldsg + LC * XP * 2 + LC * FP2 * 4 + LC * GP * 2);
    float* CW = EX + 256;
    int tid = threadIdx.x; asm volatile("" : "+v"(tid));
    const int lane = tid & 63, wid = tid >> 6, fr = lane & 15, fq = lane >> 4;
    const int nf = wid & 1, mg = wid >> 1;
    const int g = tid & 15, tl = tid >> 4;
    const int gtok = tid >> 2, gcg = tid & 3;
    const int vb = (gridDim.x % 8 == 0) ? (int)(blockIdx.x % 8) * (int)(gridDim.x / 8) + (int)(blockIdx.x / 8) : (int)blockIdx.x;
    for (int it = vb; it < 256; it += gridDim.x) {
        const int q = it & 3, h = (it >> 2) & 7, b = it >> 5;
        for (int i = tid; i < 640; i += 512) CW[i] = (i < 512) ? p.in[8][(i >> 7) * 1024 + h * 128 + (i & 127)] : p.in[9][h * 128 + (i & 127)];
        const int chq = 16 * nf + fr, ch = h * 128 + 32 * q + chq;
        const float br = p.in[11][ch], bi = p.in[13][ch];
        const float nl = -p.in[14][ch];
        const float c1 = -8.0f * (fmaxf(nl, 0.f) + log1pf(expf(-fabsf(nl))));
        const bool own = (g >> 2) == q;
        LDS_BARRIER();
        const bf16_t* zx = Z + (size_t)b * SEQ * DIN + h * 128 + 8 * g;
        const bf16_t* zg = Z + (size_t)b * SEQ * DIN + 1024 + h * 128 + 32 * q + 8 * gcg;
        float carry = 0.f;
        u32x4 raw[11], graw[2];
        const bf16_t* zp = zx + (ptrdiff_t)(8 * tl - 3) * DIN;
        const bf16_t* gp = zg + (size_t)gtok * DIN;
#pragma unroll
        for (int j = 0; j < 11; ++j) { raw[j] = (u32x4){0u, 0u, 0u, 0u}; if (8 * tl - 3 + j >= 0) raw[j] = *(const u32x4*)(zp + j * DIN); }
#pragma unroll
        for (int jj = 0; jj < 2; ++jj) graw[jj] = *(const u32x4*)(gp + jj * 128 * DIN);
        for (int c = 0; c < SEQ / LC; ++c) {
            const int t0 = c * LC;
            {
                f32x4 cwv[5][2];
#pragma unroll
                for (int k = 0; k < 5; ++k) { cwv[k][0] = *(const f32x4*)(CW + k * 128 + 8 * g); cwv[k][1] = *(const f32x4*)(CW + k * 128 + 8 * g + 4); }
#pragma unroll
                for (int hf = 0; hf < 2; ++hf) {
                    float xc[4][8];
#pragma unroll
                    for (int o = 0; o < 4; ++o)
#pragma unroll
                        for (int e = 0; e < 8; ++e) xc[o][e] = cwv[4][e >> 2][e & 3];
#pragma unroll
                    for (int jr = 0; jr < 7; ++jr) { float x[8]; unpack8(raw[4 * hf + jr], x);
#pragma unroll
                        for (int k = 0; k < 4; ++k) { const int o = jr - k; if (o >= 0 && o < 4) {
#pragma unroll
                            for (int e = 0; e < 8; ++e) xc[o][e] += cwv[k][e >> 2][e & 3] * x[e]; } } }
#pragma unroll
                    for (int o = 0; o < 4; ++o) { const int tt = 8 * tl + 4 * hf + o;
                        u32x4 w; w.x = pk_bf16(xc[o][0], xc[o][1]); w.y = pk_bf16(xc[o][2], xc[o][3]); w.z = pk_bf16(xc[o][4], xc[o][5]); w.w = pk_bf16(xc[o][6], xc[o][7]);
                        *(u32x4*)(XCb + tt * XP + 8 * g) = w;
                        if (own) { *(f32x4*)(XCf + tt * FP2 + 8 * (g & 3)) = (f32x4){xc[o][0], xc[o][1], xc[o][2], xc[o][3]}; *(f32x4*)(XCf + tt * FP2 + 8 * (g & 3) + 4) = (f32x4){xc[o][4], xc[o][5], xc[o][6], xc[o][7]}; } }
                    __builtin_amdgcn_sched_barrier(0);
                }
#pragma unroll
                for (int jj = 0; jj < 2; ++jj) *(u32x4*)(Gt + (gtok + 128 * jj) * GP + 8 * gcg) = graw[jj];
            }
            bf16x8 Br[4], Bi[4];
#pragma unroll
            for (int kk = 0; kk < 4; ++kk) { Br[kk] = *(const bf16x8*)(WrT + (ch * 128 + 32 * kk + 8 * fq)); Bi[kk] = *(const bf16x8*)(WiT + (ch * 128 + 32 * kk + 8 * fq)); }
            LDS_BARRIER();
            f32x4 ar[4], ai[4];
#pragma unroll
            for (int m = 0; m < 4; ++m) { ar[m] = (f32x4){0.f, 0.f, 0.f, 0.f}; ai[m] = (f32x4){0.f, 0.f, 0.f, 0.f};
#pragma unroll
                for (int kk = 0; kk < 4; ++kk) { const bf16x8 a = *(const bf16x8*)(XCb + (64 * mg + 16 * m + fr) * XP + 32 * kk + 8 * fq);
                    ar[m] = __builtin_amdgcn_mfma_f32_16x16x32_bf16(a, Br[kk], ar[m], 0, 0, 0); ai[m] = __builtin_amdgcn_mfma_f32_16x16x32_bf16(a, Bi[kk], ai[m], 0, 0, 0); } }
            float av[4][4], bv[4][4], Ap[4], Bp[4], At[4], Bt[4];
            float Aw = 1.f, Bw = 0.f;
#pragma unroll
            for (int m = 0; m < 4; ++m) {
#pragma unroll
                for (int e2 = 0; e2 < 2; ++e2) {
                    const int tt = 64 * mg + 16 * m + 4 * fq + 2 * e2;
                    const f32x2 pr = (f32x2){ar[m][2 * e2], ar[m][2 * e2 + 1]} + br, pi = (f32x2){ai[m][2 * e2], ai[m][2 * e2 + 1]} + bi;
                    const f32x2 xr = pr * -1.4426950409f, xi = pi * -1.4426950409f;
                    f32x2 er, ei; er.x = __builtin_amdgcn_exp2f(xr.x); er.y = __builtin_amdgcn_exp2f(xr.y); ei.x = __builtin_amdgcn_exp2f(xi.x); ei.y = __builtin_amdgcn_exp2f(xi.y);
                    const f32x2 dr = er + 1.0f, di = ei + 1.0f;
                    f32x2 r, ig; r.x = __builtin_amdgcn_rcpf(dr.x); r.y = __builtin_amdgcn_rcpf(dr.y); ig.x = __builtin_amdgcn_rcpf(di.x); ig.y = __builtin_amdgcn_rcpf(di.y);
                    const f32x2 xcv = (f32x2){XCf[tt * FP2 + chq], XCf[(tt + 1) * FP2 + chq]};
                    const f32x2 l2 = r * (c1 * 1.4426950409f);
                    f32x2 a; a.x = __builtin_amdgcn_exp2f(l2.x); a.y = __builtin_amdgcn_exp2f(l2.y);
                    const f32x2 om = 1.0f - a * a;
                    f32x2 sq; sq.x = __builtin_amdgcn_sqrtf(om.x); sq.y = __builtin_amdgcn_sqrtf(om.y);
                    const f32x2 bb = sq * ig * xcv;
                    av[m][2 * e2] = a.x; av[m][2 * e2 + 1] = a.y; bv[m][2 * e2] = bb.x; bv[m][2 * e2 + 1] = bb.y; }
                float A = 1.f, B = 0.f;
#pragma unroll
                for (int e = 0; e < 4; ++e) { B = av[m][e] * B + bv[m][e]; A = av[m][e] * A; }
                { const float A1 = __shfl_up(A, 16), B1 = __shfl_up(B, 16); if (fq >= 1) { B = A * B1 + B; A = A * A1; } }
                { const float A2 = __shfl_up(A, 32), B2 = __shfl_up(B, 32); if (fq >= 2) { B = A * B2 + B; A = A * A2; } }
                Ap[m] = __shfl_up(A, 16); Bp[m] = __shfl_up(B, 16); if (fq == 0) { Ap[m] = 1.f; Bp[m] = 0.f; }
                At[m] = __shfl(A, 48 + fr); Bt[m] = __shfl(B, 48 + fr);
                Bw = At[m] * Bw + Bt[m]; Aw = At[m] * Aw;
            }
            if (fq == 0) { EX[((mg * 2 + nf) * 16 + fr) * 2] = Aw; EX[((mg * 2 + nf) * 16 + fr) * 2 + 1] = Bw; }
            if (c + 1 < SEQ / LC) {
                zp += LC * DIN; gp += LC * DIN;
                asm volatile("" : "+v"(zp), "+v"(gp));
#pragma unroll
                for (int j = 0; j < 11; ++j) raw[j] = *(const u32x4*)(zp + j * DIN);
#pragma unroll
                for (int jj = 0; jj < 2; ++jj) graw[jj] = *(const u32x4*)(gp + jj * 128 * DIN);
            }
            LDS_BARRIER();
            float cin = carry, cnext = carry;
#pragma unroll
            for (int mm = 0; mm < 4; ++mm) { const float A = EX[((mm * 2 + nf) * 16 + fr) * 2], B = EX[((mm * 2 + nf) * 16 + fr) * 2 + 1]; cnext = A * cnext + B; if (mm < mg) cin = A * cin + B; }
            carry = cnext;
            float cm = cin;
#pragma unroll
            for (int m = 0; m < 4; ++m) {
                float hs = Ap[m] * cm + Bp[m];
#pragma unroll
                for (int e = 0; e < 4; ++e) { const int tt = 64 * mg + 16 * m + 4 * fq + e;
                    hs = av[m][e] * hs + bv[m][e];
                    const float gt = bf2f(Gt[tt * GP + chq]);
                    const float u2 = 1.5957691216f * (gt + 0.044715f * gt * gt * gt);
                    const float y = hs * gt * sigmoidf_fast(u2);
                    Yt[tt * GP + chq] = (bf16_t)(pk_bf16(y, 0.f) & 0xffffu); }
                cm = At[m] * cm + Bt[m];
            }
            LDS_BARRIER();
#pragma unroll
            for (int jj = 0; jj < 2; ++jj) *(u32x4*)(Y + blk_off(b * SEQ + t0 + gtok + 128 * jj, h * 128 + 32 * q + 8 * gcg, M_TOK)) = *(const u32x4*)(Yt + (gtok + 128 * jj) * GP + 8 * gcg);
            LDS_BARRIER();
        }
    }
}

__device__ void phase_shortconv(const Params& p) {
    const bf16_t* __restrict__ Z = (const bf16_t*)(p.ws + WS_HB);
    bf16_t* __restrict__ Y = (bf16_t*)(p.ws + WS_Y);
    const float* __restrict__ w = p.in[15];
    for (int item = blockIdx.x * 512 + threadIdx.x; item < (M_TOK / 16) * 128; item += gridDim.x * 512) {
        const int cgp = item & 127, run = item >> 7, t0 = run * 16;
        float w0[8], w1[8], w2[8], p1[8], p2[8];
#pragma unroll
        for (int j = 0; j < 8; ++j) { w0[j] = w[8 * cgp + j]; w1[j] = w[1024 + 8 * cgp + j]; w2[j] = w[2048 + 8 * cgp + j]; p1[j] = 0.f; p2[j] = 0.f; }
        if ((t0 & (SEQ - 1)) != 0) {
            float c[8], x[8];
            const bf16_t* b1 = Z + (size_t)(t0 - 1) * DIN + 8 * cgp; unpack8(*(const u32x4*)(b1 + 3072), c); unpack8(*(const u32x4*)(b1 + 4096), x);
#pragma unroll
            for (int j = 0; j < 8; ++j) p1[j] = c[j] * x[j];
            const bf16_t* b2 = Z + (size_t)(t0 - 2) * DIN + 8 * cgp; unpack8(*(const u32x4*)(b2 + 3072), c); unpack8(*(const u32x4*)(b2 + 4096), x);
#pragma unroll
            for (int j = 0; j < 8; ++j) p2[j] = c[j] * x[j];
        }
#pragma unroll 4
        for (int tt = 0; tt < 16; ++tt) {
            const bf16_t* base = Z + (size_t)(t0 + tt) * DIN + 8 * cgp;
            float bb[8], c[8], x[8], y[8];
            unpack8(*(const u32x4*)(base + 2048), bb); unpack8(*(const u32x4*)(base + 3072), c); unpack8(*(const u32x4*)(base + 4096), x);
#pragma unroll
            for (int j = 0; j < 8; ++j) { const float p0 = c[j] * x[j]; y[j] = bb[j] * (w0[j] * p2[j] + w1[j] * p1[j] + w2[j] * p0); p2[j] = p1[j]; p1[j] = p0; }
            u32x4 o; o.x = pk_bf16(y[0], y[1]); o.y = pk_bf16(y[2], y[3]); o.z = pk_bf16(y[4], y[5]); o.w = pk_bf16(y[6], y[7]);
            *(u32x4*)(Y + blk_off(t0 + tt, 1024 + 8 * cgp, M_TOK)) = o;
        }
    }
}


#define XB_TMO      128
#define XB_XCNT(j)  (256  + 64 * (j))
#define XB_XSUB(j)  (1280 + 64 * (j))
#define XB_XGEN(j)  (2304 + 64 * (j))
#define XB_TOP      3328
#define XB_TOPGEN   3392
#define XCD_BAR_WORDS 3456
#define XB_SPIN_CAP (1u << 18)
__device__ __forceinline__ unsigned xb_ld(unsigned* p)              { return __hip_atomic_load(p, __ATOMIC_RELAXED, __HIP_MEMORY_SCOPE_AGENT); }
__device__ __forceinline__ unsigned xb_add(unsigned* p, unsigned v) { return __hip_atomic_fetch_add(p, v, __ATOMIC_RELAXED, __HIP_MEMORY_SCOPE_AGENT); }
__device__ __forceinline__ unsigned xb_xcc_id() { return (unsigned)__builtin_amdgcn_s_getreg((3 << 11) | 20) & 0xFu; }
#define XB_SPIN(cond, bar) do { unsigned _sp = 0; while (cond) {   \
    if ((++_sp & 255u) == 0u) { if (xb_ld(&(bar)[XB_TMO])) break; if (_sp > XB_SPIN_CAP) { atomicAdd(&(bar)[XB_TMO], 1u); break; } } } } while (0)
struct XcdBarrier { unsigned* bar; unsigned x; volatile LAS unsigned* st; };
__device__ __forceinline__ XcdBarrier xcd_barrier_post(unsigned* bar, volatile LAS unsigned* st) {
    XcdBarrier b; b.bar = bar; b.x = xb_xcc_id(); b.st = st;
    if (threadIdx.x == 0) (void)xb_add(&bar[XB_XCNT(b.x)], 1u);
    return b;
}
__device__ __forceinline__ void xcd_barrier_complete(unsigned* bar, unsigned x, unsigned& nloc, unsigned& nx) {
    const unsigned G = gridDim.x * gridDim.y * gridDim.z;
    unsigned sum, cnt, mine, sp = 0u;
    for (;;) {
        sum = 0u; cnt = 0u; mine = 0u;
#pragma unroll
        for (unsigned j = 0; j < 16; ++j) { const unsigned c = xb_ld(&bar[XB_XCNT(j)]); sum += c; cnt += (c > 0u) ? 1u : 0u; mine = (j == x) ? c : mine; }
        if (sum == G) break;
        __builtin_amdgcn_s_sleep(1);
        if ((++sp & 255u) == 0u) { if (xb_ld(&bar[XB_TMO])) break; if (sp > XB_SPIN_CAP) { atomicAdd(&bar[XB_TMO], 1u); break; } }
    }
    nloc = mine > 0u ? mine : 1u; nx = cnt > 0u ? cnt : 1u;
}
__device__ __forceinline__ void xcd_barrier(const XcdBarrier& b) {
    asm volatile("s_waitcnt vmcnt(0)" ::: "memory");
    __syncthreads();
    if (threadIdx.x == 0) {
        unsigned* bar = b.bar;
        __builtin_amdgcn_s_waitcnt(0);
        unsigned nloc = b.st[0], nx = b.st[1];
        if (nloc == 0u) { xcd_barrier_complete(bar, b.x, nloc, nx); b.st[0] = nloc; b.st[1] = nx; }
        const unsigned old = xb_add(&bar[XB_XSUB(b.x)], 1u);
        const unsigned gen = old / nloc;
        if (old + 1u == (gen + 1u) * nloc) {
            __builtin_amdgcn_fence(__ATOMIC_RELEASE, "agent");
            asm volatile("s_waitcnt vmcnt(0)" ::: "memory");
            const unsigned og = xb_add(&bar[XB_TOP], 1u);
            const unsigned tg = og / nx;
            if (og + 1u == (tg + 1u) * nx) xb_add(&bar[XB_TOPGEN], 1u);
            else XB_SPIN(xb_ld(&bar[XB_TOPGEN]) == tg, bar);
            __builtin_amdgcn_fence(__ATOMIC_ACQUIRE, "agent");
            xb_add(&bar[XB_XGEN(b.x)], 1u);
            asm volatile("s_waitcnt vmcnt(0)" ::: "memory");
        } else {
            XB_SPIN(xb_ld(&bar[XB_XGEN(b.x)]) == gen, bar);
            __builtin_amdgcn_fence(__ATOMIC_ACQUIRE, "agent");
            asm volatile("s_waitcnt vmcnt(0)" ::: "memory");
        }
    }
    __syncthreads();
}

__global__ void __launch_bounds__(512, 2) mega_fwd(Params p) {
    extern __shared__ __attribute__((aligned(16))) unsigned char lds[];
    cg::grid_group grid = cg::this_grid();
    LAS unsigned char* lds3 = (LAS unsigned char*)lds;
    const int G = gridDim.x, c = blockIdx.x;
    if (threadIdx.x < 4) ((LAS unsigned*)(lds3 + 131072))[threadIdx.x] = 0u;
    __syncthreads();
    const XcdBarrier xbar = xcd_barrier_post((unsigned*)(p.ws + WS_BAR), (volatile LAS unsigned*)(lds3 + 131072));
    bf16_t* XB = (bf16_t*)(p.ws + WS_A1); bf16_t* HB = (bf16_t*)(p.ws + WS_HB); bf16_t* Fb = (bf16_t*)(p.ws + WS_F); bf16_t* Yb = (bf16_t*)(p.ws + WS_Y);
    float* RS = (float*)(p.ws + WS_RS);

    phase_convert<false>(p, lds, 0, 2112);
    phase_prenorm(p.in[0], XB, RS);
    if (p.ws == nullptr) grid.sync();
    xcd_barrier(xbar);
    { pg8::Gemm g{XB, (const bf16_t*)(p.ws + WS_WGU1), M_TOK, 2 * DFF, DM}; pg8::StaticOrder S; S.init(M_TOK, 2 * DFF, G, c); pg8::EpiSwiGLU E{HB, M_TOK}; pg8::gemm_phase(lds3, g, S, E); }
    xcd_barrier(xbar);
    phase_convert<true>(p, lds, 2112, 5120);
    { pg8::Gemm g{HB, (const bf16_t*)(p.ws + WS_WD1), M_TOK, DM, DFF}; pg8::StaticOrder S; S.init(M_TOK, DM, G, c, 4); pg8::EpiBf16 E{Fb, DM}; pg8::gemm_phase(lds3, g, S, E); }
    xcd_barrier(xbar);
    phase_norm<false, false>(Fb, nullptr, XB, nullptr, RS, p.in[5], 0.5f);
    xcd_barrier(xbar);
    { pg8::Gemm g{XB, (const bf16_t*)(p.ws + WS_WIN), M_TOK, DIN, DM}; pg8::StaticOrder S; S.init(M_TOK, DIN, G, c); pg8::EpiBf16 E{HB, DIN}; pg8::gemm_phase(lds3, g, S, E); }
    xcd_barrier(xbar);
    phase_shortconv(p);
    if (__builtin_amdgcn_readfirstlane(threadIdx.x) >= 256) __builtin_amdgcn_s_setprio(1);
    phase_lru(p, lds);
    __builtin_amdgcn_s_setprio(0);
    xcd_barrier(xbar);
    { pg8::Gemm g{Yb, (const bf16_t*)(p.ws + WS_WOUT), M_TOK, DM, DM}; pg8::StaticOrder S; S.init(M_TOK, DM, G, c, 4); pg8::EpiBf16 E{Fb, DM}; pg8::gemm_phase(lds3, g, S, E); }
    xcd_barrier(xbar);
    phase_norm<false, false>(Fb, nullptr, XB, nullptr, RS, p.in[17], 1.0f);
    xcd_barrier(xbar);
    { pg8::Gemm g{XB, (const bf16_t*)(p.ws + WS_WGU2), M_TOK, 2 * DFF, DM}; pg8::StaticOrder S; S.init(M_TOK, 2 * DFF, G, c); pg8::EpiSwiGLU E{HB, M_TOK}; pg8::gemm_phase(lds3, g, S, E); }
    xcd_barrier(xbar);
    { pg8::Gemm g{HB, (const bf16_t*)(p.ws + WS_WD2), M_TOK, DM, DFF}; pg8::StaticOrder S; S.init(M_TOK, DM, G, c, 4); pg8::EpiBf16 E{Fb, DM}; pg8::gemm_phase(lds3, g, S, E); }
    xcd_barrier(xbar);
    phase_norm<false, true>(Fb, nullptr, XB, p.out, RS, p.in[22], 0.5f);
}

extern "C" void kernel_launch(void* const* d_in, const int* in_sizes, int n_in, void* d_out, int out_size, void* d_ws, size_t ws_size, hipStream_t stream) {
    static int grid_blocks = 0;
    if (!grid_blocks) {
        int dev = 0, cus = 0, per_cu = 0;
        hipGetDevice(&dev);
        hipDeviceGetAttribute(&cus, hipDeviceAttributeMultiprocessorCount, dev);
        if (hipFuncSetAttribute((const void*)mega_fwd, hipFuncAttributeMaxDynamicSharedMemorySize, LDS_BYTES) != hipSuccess) fprintf(stderr, "hipFuncSetAttribute failed\n");
        if (hipOccupancyMaxActiveBlocksPerMultiprocessor(&per_cu, (const void*)mega_fwd, 512, LDS_BYTES) != hipSuccess || per_cu < 1) { fprintf(stderr, "occupancy query gave %d\n", per_cu); per_cu = 1; }
        (void)hipGetLastError();
        if (cus <= 0) cus = 256;
        grid_blocks = cus * per_cu;
        if (ws_size < WS_END) fprintf(stderr, "workspace too small: %zu < %zu\n", ws_size, (size_t)WS_END);
    }
    Params p{};
    for (int i = 0; i < 23; ++i) p.in[i] = (const float*)d_in[i];
    p.out = (float*)d_out; p.ws = (unsigned char*)d_ws;
    if (hipMemsetAsync((char*)d_ws + WS_BAR, 0, 16384, stream) != hipSuccess) fprintf(stderr, "memset failed\n");
    void* args[] = {&p};
    hipError_t e = hipLaunchCooperativeKernel((const void*)mega_fwd, dim3(grid_blocks), dim3(512), args, LDS_BYTES, stream);
    if (e != hipSuccess) fprintf(stderr, "cooperative launch failed: %s (grid %d)\n", hipGetErrorString(e), grid_blocks);
}
```
